# Optimizing an MI355X kernel written in HIP

```python
import math
import jax, jax.numpy as jnp
from jax import lax
import numpy as np

D_MODEL = 1024
BATCH = 8
SEQ = 4096
DEPTH = 4

N_A_LAYERS = DEPTH // 2
N_B_LAYERS = DEPTH - N_A_LAYERS

CHUNK = 128
A_WIDTH = 2 * D_MODEL
A_GROUPS = 8
A_GROUP_DIM = A_WIDTH // A_GROUPS

N_HEADS = 16
N_KV_HEADS = 4
Q_PER_KV = N_HEADS // N_KV_HEADS
HEAD_DIM = 64
WINDOW = 128
BLOCK = 128

N_BUCKETS = 32
MAX_DISTANCE = 128

D_FF = 4 * D_MODEL
EPS = 1e-6

kernel_name = "yoco_sgu_swa_sink_hybrid"


def rms_norm(x, g):
    xf = x.astype(jnp.float32)
    y = xf * lax.rsqrt(jnp.mean(xf * xf, axis=-1, keepdims=True) + EPS)
    return (y * g.astype(jnp.float32)).astype(x.dtype)


def layer_norm(x, g):
    xf = x.astype(jnp.float32)
    mu = jnp.mean(xf, axis=-1, keepdims=True)
    xc = xf - mu
    y = xc * lax.rsqrt(jnp.mean(xc * xc, axis=-1, keepdims=True) + EPS)
    return (y * g.astype(jnp.float32)).astype(x.dtype)


def t5_causal_bucket(dist):
    max_exact = N_BUCKETS // 2
    d = jnp.maximum(dist, 0)
    log_ratio = jnp.log(jnp.maximum(d, 1).astype(jnp.float32) / max_exact) / math.log(MAX_DISTANCE / max_exact)
    large = jnp.minimum(max_exact + (log_ratio * (N_BUCKETS - max_exact)).astype(jnp.int32), N_BUCKETS - 1)
    return jnp.where(d < max_exact, d, large)


def band_bias_and_mask(rel_bias, n_blocks):
    qi = jnp.arange(BLOCK)[:, None]
    kj = jnp.arange(2 * BLOCK)[None, :]
    dist = qi + BLOCK - kj
    in_window = (dist >= 0) & (dist < WINDOW)
    bias = jnp.transpose(rel_bias.astype(jnp.float32)[t5_causal_bucket(dist)], (2, 0, 1))
    k_pos = (jnp.arange(n_blocks)[:, None, None] - 1) * BLOCK + kj[None]
    mask = in_window[None] & (k_pos >= 0)
    return bias, mask


def chunked_sgu_mixer(h, w_in, ln_g, w_s, b_s, w_out):
    B, S, _ = h.shape
    uv = jax.nn.gelu(h @ w_in, approximate=False)
    u, v = jnp.split(uv, 2, axis=-1)
    v = layer_norm(v, ln_g).reshape(B, S // CHUNK, CHUNK, A_GROUPS, A_GROUP_DIM)
    causal = jnp.tril(jnp.ones((CHUNK, CHUNK), dtype=bool))
    w_causal = jnp.where(causal[None], w_s, jnp.zeros_like(w_s))
    mixed = jnp.einsum('gij,bnjgd->bnigd', w_causal, v) + jnp.transpose(b_s)[None, None, :, :, None]
    gated = u * mixed.reshape(B, S, A_WIDTH)
    return gated @ w_out


def shared_band_kv(h, kv_norm_g, w_k, w_v):
    B, S, _ = h.shape
    nb = S // BLOCK
    hn = rms_norm(h, kv_norm_g)
    k = (hn @ w_k).reshape(B, nb, BLOCK, N_KV_HEADS, HEAD_DIM)
    v = (hn @ w_v).reshape(B, nb, BLOCK, N_KV_HEADS, HEAD_DIM)

    def band(t):
        prev = jnp.pad(t, ((0, 0), (1, 0), (0, 0), (0, 0), (0, 0)))[:, :-1]
        return jnp.concatenate([prev, t], axis=2)

    return band(k), band(v)


def sliding_sink_attention(h, k_band, v_band, w_q, sinks, w_o, band_bias, band_mask):
    B, S, _ = h.shape
    nb = S // BLOCK
    q = (h @ w_q).reshape(B, nb, BLOCK, N_KV_HEADS, Q_PER_KV, HEAD_DIM)
    logits = jnp.einsum('bnqkgd,bnjkd->bnkgqj', q, k_band).astype(jnp.float32) * (HEAD_DIM ** -0.5)
    logits = logits + band_bias.reshape(N_KV_HEADS, Q_PER_KV, BLOCK, 2 * BLOCK)
    logits = jnp.where(band_mask[None, :, None, None], logits, jnp.finfo(jnp.float32).min)
    sink = sinks.astype(jnp.float32).reshape(N_KV_HEADS, Q_PER_KV)[None, None, :, :, None, None]
    m = jnp.maximum(jnp.max(logits, axis=-1, keepdims=True), sink)
    e = jnp.exp(logits - m)
    probs = e / (jnp.sum(e, axis=-1, keepdims=True) + jnp.exp(sink - m))
    out = jnp.einsum('bnkgqj,bnjkd->bnqkgd', probs.astype(v_band.dtype), v_band)
    return out.reshape(B, S, N_HEADS * HEAD_DIM) @ w_o


def sq_relu_mlp(h, w1, w2):
    return jnp.square(jax.nn.relu(h @ w1)) @ w2


def setup_inputs(seed: int = 0) -> dict:
    key = jax.random.key(seed)
    ks = jax.random.split(key, 20)
    f32 = jnp.float32

    def nrm(k, shape, scale):
        return jax.random.normal(k, shape, f32) * scale

    return {
        "x": jax.random.normal(ks[0], (BATCH, SEQ, D_MODEL), f32),
        "mix_norm_g": 1.0 + nrm(ks[1], (DEPTH, D_MODEL), 0.05),
        "ffn_norm_g": 1.0 + nrm(ks[2], (DEPTH, D_MODEL), 0.05),
        "a_w_in": nrm(ks[3], (N_A_LAYERS, D_MODEL, 2 * A_WIDTH), D_MODEL ** -0.5),
        "a_ln_g": 1.0 + nrm(ks[4], (N_A_LAYERS, A_WIDTH), 0.05),
        "a_w_spatial": nrm(ks[5], (N_A_LAYERS, A_GROUPS, CHUNK, CHUNK), CHUNK ** -0.5),
        "a_b_spatial": 1.0 + nrm(ks[6], (N_A_LAYERS, A_GROUPS, CHUNK), 0.1),
        "a_w_out": nrm(ks[7], (N_A_LAYERS, A_WIDTH, D_MODEL), A_WIDTH ** -0.5),
        "kv_norm_g": 1.0 + nrm(ks[8], (D_MODEL,), 0.05),
        "w_k": nrm(ks[9], (D_MODEL, N_KV_HEADS * HEAD_DIM), D_MODEL ** -0.5),
        "w_v": nrm(ks[10], (D_MODEL, N_KV_HEADS * HEAD_DIM), D_MODEL ** -0.5),
        "b_w_q": nrm(ks[11], (N_B_LAYERS, D_MODEL, N_HEADS * HEAD_DIM), D_MODEL ** -0.5),
        "b_sinks": nrm(ks[12], (N_B_LAYERS, N_HEADS), 0.5),
        "b_w_o": nrm(ks[13], (N_B_LAYERS, N_HEADS * HEAD_DIM, D_MODEL), (N_HEADS * HEAD_DIM) ** -0.5),
        "rel_bias": nrm(ks[14], (N_BUCKETS, N_HEADS), 0.5),
        "ffn_w1": nrm(ks[15], (DEPTH, D_MODEL, D_FF), D_MODEL ** -0.5),
        "ffn_w2": nrm(ks[16], (DEPTH, D_FF, D_MODEL), 0.5 * D_FF ** -0.5),
        "final_norm_g": 1.0 + nrm(ks[17], (D_MODEL,), 0.05),
    }


def reference(x, mix_norm_g, ffn_norm_g, a_w_in, a_ln_g, a_w_spatial, a_b_spatial, a_w_out,
              kv_norm_g, w_k, w_v, b_w_q, b_sinks, b_w_o, rel_bias, ffn_w1, ffn_w2, final_norm_g):
    _, S, _ = x.shape
    band_bias, band_mask = band_bias_and_mask(rel_bias, S // BLOCK)
    h = x
    k_band = None
    v_band = None
    for layer in range(DEPTH):
        hn = rms_norm(h, mix_norm_g[layer])
        if layer < N_A_LAYERS:
            i = layer
            h = h + chunked_sgu_mixer(hn, a_w_in[i], a_ln_g[i], a_w_spatial[i], a_b_spatial[i], a_w_out[i])
        else:
            if layer == N_A_LAYERS:
                k_band, v_band = shared_band_kv(h, kv_norm_g, w_k, w_v)
                hn = rms_norm(h, mix_norm_g[layer])
            j = layer - N_A_LAYERS
            h = h + sliding_sink_attention(hn, k_band, v_band, b_w_q[j], b_sinks[j], b_w_o[j], band_bias, band_mask)
        h = h + sq_relu_mlp(rms_norm(h, ffn_norm_g[layer]), ffn_w1[layer], ffn_w2[layer])
    return rms_norm(h, final_norm_g)
```

```cpp
#include <hip/hip_runtime.h>
#include <hip/hip_cooperative_groups.h>
#include <cstdio>
#include <cstdint>
namespace cg = cooperative_groups;
__device__ __forceinline__ int opaque_tid() { int t = threadIdx.x; asm volatile("" : "+v"(t)); return t; }
namespace pg8 {
#define PG8_LAS __attribute__((address_space(3)))
typedef unsigned short bf16_t;
typedef short bf16x8 __attribute__((ext_vector_type(8)));
typedef float f32x4 __attribute__((ext_vector_type(4)));
typedef unsigned u32x4 __attribute__((ext_vector_type(4)));
constexpr int BM = 256, BK = 64, HALF = 128, HTB = HALF * BK * 2  , STAGE_BYTES = 8 * HTB, NXCD = 8, WGM = 8;

__host__ __device__ __forceinline__ int lds_byte(int r, int c) { const int st = (r >> 4) * 2 + (c >> 5), rr = r & 15, cc = c & 31, ob = rr * 64 + cc * 2; return st * 1024 + (ob ^ (((ob >> 9) & 1) << 5)); }
__host__ __device__ __forceinline__ void stage_rc(int b, int& R, int& C) { const int st = b / 1024, sb = b % 1024, swz = sb ^ (((sb >> 9) & 1) << 5); R = (st >> 1) * 16 + swz / 64; C = (st & 1) * 32 + (swz % 64) / 2; }
__host__ __device__ __forceinline__ int perm32(int rho) { const int n = rho >> 4, i = rho & 15; return 8 * (i >> 2) + 4 * n + (i & 3); }

struct Unit { int pm, pn; };
struct Gemm { const bf16_t* A; const bf16_t* Bt; int M, N, K; };

struct StaticOrder {
    int nM, nN, nwg, G, c;
    __host__ __device__ void init(int M, int N, int G_, int c_) { nM = M / BM; nN = N / BM; nwg = nM * nN; G = G_; c = c_; }
    __host__ __device__ bool next(int i, Unit& u) const {
        const long L = (long)i * G + c; if (L >= nwg) return false;
        int wgid = (int)L; { const int q = nwg / NXCD, r = nwg % NXCD, xcd = wgid % NXCD, off = wgid / NXCD; wgid = (xcd < r ? xcd * (q + 1) : r * (q + 1) + (xcd - r) * q) + off; }
        const int nig = WGM * nN, gid = wgid / nig, fm = gid * WGM, gsz = (nM - fm) < WGM ? (nM - fm) : WGM;
        u.pm = fm + ((wgid % nig) % gsz); u.pn = (wgid % nig) / gsz; return true;
    }
    __device__ __forceinline__ void a_ready(const Unit&) const {}
    __device__ __forceinline__ void done(const Unit&) const {}
};
__device__ __forceinline__ unsigned cvt_pk_bf16(float lo, float hi) { unsigned r; asm volatile("v_cvt_pk_bf16_f32 %0, %1, %2" : "=v"(r) : "v"(lo), "v"(hi)); return r; }
typedef float f32x2 __attribute__((ext_vector_type(2)));
__device__ __forceinline__ f32x2 gelu_pk(f32x2 v) {
    const f32x2 av = __builtin_elementwise_abs(v), d = av * 0.2316418882f + 1.0f;
    f32x2 t; t.x = __builtin_amdgcn_rcpf(d.x); t.y = __builtin_amdgcn_rcpf(d.y);
    f32x2 q = t * 0.5307027145f + (-0.7265760135f); q = q * t + 0.7107068705f; q = q * t + (-0.142248368f); q = q * t + 0.127414796f; q = q * t;
    const f32x2 s = (v * v) * (-0.72134752044f);
    f32x2 e; e.x = __builtin_amdgcn_exp2f(s.x); e.y = __builtin_amdgcn_exp2f(s.y);
    const f32x2 m = v * (q * e), r = v - m;
    f32x2 o; o.x = v.x < 0.f ? m.x : r.x; o.y = v.y < 0.f ? m.y : r.y; return o;
}
template <class Epi, class Sched, bool ALIGN_EPI = false, bool SP2 = false>
__device__ __forceinline__ void gemm_phase(PG8_LAS unsigned char* lds, const Gemm g, const Sched& S, const Epi& E) {
    const int tid = opaque_tid(), wid = __builtin_amdgcn_readfirstlane(tid >> 6), lane = tid & 63, wr = wid >> 2, wc = wid & 3, fr = lane & 15, fq = lane >> 4;
    const int K = g.K, nt = K / BK;
    unsigned voffA[2], voffB[2];
#pragma unroll
    for (int i = 0; i < 2; ++i) { int R, C; stage_rc(tid * 16 + i * 8192, R, C); const int Rb = Epi::PERM ? ((R & ~31) + perm32(R & 31)) : R;
        voffA[i] = (unsigned)(R * K + C) * 2u; voffB[i] = (unsigned)(Rb * K + C) * 2u; }
    const size_t kstep = (size_t)(BK * 2);
    const size_t hstep = (size_t)HALF * K * 2;
    const size_t tstep = 2 * hstep;
    const unsigned ldsw = (unsigned)wid * 1024u;
    const int aoff = lds_byte(wr * 64 + fr, fq * 8), boff = lds_byte(wc * 32 + fr, fq * 8);
#define PG8_SA(b, h) (((b) * 2 + (h)) * HTB)
#define PG8_SB(b, h) ((4 + (b) * 2 + (h)) * HTB)
#define PG8_STAGE(bufoff, gbase, voff) do { _Pragma("unroll") for (int _i = 0; _i < 2; ++_i) \
        __builtin_amdgcn_global_load_lds((const unsigned*)((const char*)(gbase) + (voff)[_i]), (PG8_LAS unsigned*)(lds + (bufoff) + ldsw + _i * 8192), 16, 0, 0); } while (0)
#define PG8_LDA(dst, b, h) do { _Pragma("unroll") for (int m = 0; m < 4; ++m) _Pragma("unroll") for (int k = 0; k < 2; ++k) dst[m][k] = *(const PG8_LAS bf16x8*)(lds + PG8_SA(b, h) + aoff + m * 2048 + k * 1024); } while (0)
#define PG8_LDB(dst, b, h) do { _Pragma("unroll") for (int n = 0; n < 2; ++n) _Pragma("unroll") for (int k = 0; k < 2; ++k) dst[n][k] = *(const PG8_LAS bf16x8*)(lds + PG8_SB(b, h) + boff + n * 2048 + k * 1024); } while (0)
#define PG8_MMA(ai, bj, At, Bt) do { __builtin_amdgcn_s_setprio(1); _Pragma("unroll") for (int m = 0; m < 4; ++m) _Pragma("unroll") for (int n = 0; n < 2; ++n) _Pragma("unroll") for (int k = 0; k < 2; ++k) \
        acc[ai][bj][m][n] = __builtin_amdgcn_mfma_f32_16x16x32_bf16(Bt[n][k], At[m][k], acc[ai][bj][m][n], 0, 0, 0); __builtin_amdgcn_s_setprio(0); } while (0)
#define PG8_WAIT_V(n) asm volatile("s_waitcnt vmcnt(" #n ")" ::: "memory")
#define PG8_WAIT_L(n) asm volatile("s_waitcnt lgkmcnt(" #n ")" ::: "memory")
#define PG8_BAR __builtin_amdgcn_s_barrier()
#define PG8_SCHED __builtin_amdgcn_sched_barrier(0)
    Unit cur, nxt; int ui = 0;
    if (!S.next(0, cur)) return;
    f32x4 acc[2][2][4][2];
#pragma unroll
    for (int a = 0; a < 2; ++a)
#pragma unroll
        for (int b = 0; b < 2; ++b)
#pragma unroll
            for (int m = 0; m < 4; ++m)
#pragma unroll
                for (int n = 0; n < 2; ++n) acc[a][b][m][n] = (f32x4){0.f, 0.f, 0.f, 0.f};
    bf16x8 At[4][2], B0[2][2], B1[2][2];
    const char* cA = (const char*)g.A + (size_t)cur.pm * tstep; const char* cB = (const char*)g.Bt + (size_t)cur.pn * tstep;
    S.a_ready(cur);
    if constexpr (SP2) {
        PG8_STAGE(PG8_SB(0, 0), cB, voffB); PG8_STAGE(PG8_SB(0, 1), cB + hstep, voffB); PG8_STAGE(PG8_SA(0, 0), cA, voffA); PG8_STAGE(PG8_SA(0, 1), cA + hstep, voffA);
        if (wr == 1) PG8_BAR;
        PG8_WAIT_V(2); PG8_BAR;
        PG8_STAGE(PG8_SB(1, 0), cB + kstep, voffB); PG8_STAGE(PG8_SA(1, 0), cA + kstep, voffA); PG8_STAGE(PG8_SB(1, 1), cB + hstep + kstep, voffB);
        PG8_WAIT_V(6); PG8_BAR;
    } else {
        PG8_STAGE(PG8_SB(0, 0), cB, voffB); PG8_STAGE(PG8_SA(0, 0), cA, voffA); PG8_STAGE(PG8_SB(0, 1), cB + hstep, voffB); PG8_STAGE(PG8_SA(0, 1), cA + hstep, voffA);
        if (wr == 1) PG8_BAR;
        PG8_WAIT_V(4); PG8_BAR;
        PG8_STAGE(PG8_SB(1, 0), cB + kstep, voffB); PG8_STAGE(PG8_SA(1, 0), cA + kstep, voffA); PG8_STAGE(PG8_SB(1, 1), cB + hstep + kstep, voffB);
        PG8_WAIT_V(6); PG8_BAR;
    }
    for (;;) {
        const bool has_next = S.next(ui + 1, nxt);
        const char* nA = has_next ? (const char*)g.A + (size_t)nxt.pm * tstep : cA; const char* nB = has_next ? (const char*)g.Bt + (size_t)nxt.pn * tstep : cB;
        for (int t = 0; t < nt; t += 2) {
            const bool last = (t == nt - 2);
            const char* a1 = cA + (size_t)(t + 1) * kstep;
            const char* a2 = last ? nA : cA + (size_t)(t + 2) * kstep; const char* b2 = last ? nB : cB + (size_t)(t + 2) * kstep;
            const char* a3 = a2 + kstep; const char* b3 = b2 + kstep;
            if (last && has_next) S.a_ready(nxt);
            if constexpr (SP2) {
            PG8_LDB(B0, 0, 0); PG8_LDB(B1, 0, 1); PG8_SCHED; PG8_LDA(At, 0, 0); PG8_STAGE(PG8_SA(1, 1), a1 + hstep, voffA);
            PG8_WAIT_V(8); PG8_WAIT_L(0); PG8_BAR; PG8_MMA(0, 0, At, B0); PG8_MMA(0, 1, At, B1); PG8_BAR; PG8_SCHED;
            PG8_LDA(At, 0, 1); PG8_STAGE(PG8_SB(0, 0), b2, voffB); PG8_STAGE(PG8_SB(0, 1), b2 + hstep, voffB); PG8_STAGE(PG8_SA(0, 0), a2, voffA);
            PG8_WAIT_V(8); PG8_WAIT_L(0); PG8_BAR; PG8_MMA(1, 0, At, B0); PG8_MMA(1, 1, At, B1); PG8_BAR; PG8_SCHED;
            PG8_LDB(B0, 1, 0); PG8_LDB(B1, 1, 1); PG8_SCHED; PG8_LDA(At, 1, 0); PG8_STAGE(PG8_SA(0, 1), a2 + hstep, voffA);
            PG8_WAIT_V(8); PG8_WAIT_L(0); PG8_BAR; PG8_MMA(0, 0, At, B0); PG8_MMA(0, 1, At, B1); PG8_BAR; PG8_SCHED;
            PG8_LDA(At, 1, 1); PG8_STAGE(PG8_SB(1, 0), b3, voffB); PG8_STAGE(PG8_SB(1, 1), b3 + hstep, voffB); PG8_STAGE(PG8_SA(1, 0), a3, voffA);
            PG8_WAIT_V(8); PG8_WAIT_L(0); PG8_BAR; PG8_MMA(1, 0, At, B0); PG8_MMA(1, 1, At, B1); PG8_BAR; PG8_SCHED;
            } else {
            PG8_LDB(B0, 0, 0); PG8_SCHED; PG8_LDA(At, 0, 0); PG8_STAGE(PG8_SA(1, 1), a1 + hstep, voffA);
            PG8_WAIT_L(8); PG8_BAR; PG8_WAIT_L(0); PG8_MMA(0, 0, At, B0); PG8_BAR; PG8_SCHED;
            PG8_LDB(B1, 0, 1); PG8_STAGE(PG8_SB(0, 0), b2, voffB);
            PG8_BAR; PG8_WAIT_L(0); PG8_MMA(0, 1, At, B1); PG8_BAR;
            PG8_LDA(At, 0, 1); PG8_STAGE(PG8_SA(0, 0), a2, voffA);
            PG8_BAR; PG8_WAIT_L(0); PG8_MMA(1, 0, At, B0); PG8_BAR; PG8_SCHED;
            PG8_STAGE(PG8_SB(0, 1), b2 + hstep, voffB);
            PG8_WAIT_V(6); PG8_BAR; PG8_MMA(1, 1, At, B1); PG8_BAR;
            PG8_LDB(B0, 1, 0); PG8_SCHED; PG8_LDA(At, 1, 0); PG8_STAGE(PG8_SA(0, 1), a2 + hstep, voffA);
            PG8_WAIT_L(8); PG8_BAR; PG8_WAIT_L(0); PG8_MMA(0, 0, At, B0); PG8_BAR; PG8_SCHED;
            PG8_LDB(B1, 1, 1); PG8_STAGE(PG8_SB(1, 0), b3, voffB);
            PG8_BAR; PG8_WAIT_L(0); PG8_MMA(0, 1, At, B1); PG8_BAR;
            PG8_LDA(At, 1, 1); PG8_STAGE(PG8_SA(1, 0), a3, voffA);
            PG8_BAR; PG8_WAIT_L(0); PG8_MMA(1, 0, At, B0); PG8_BAR; PG8_SCHED;
            PG8_STAGE(PG8_SB(1, 1), b3 + hstep, voffB);
            PG8_WAIT_V(6); PG8_BAR; PG8_MMA(1, 1, At, B1); PG8_BAR;
            }
        }
        if constexpr (ALIGN_EPI) { if (wr == 0) PG8_BAR; }
        if constexpr (!Epi::AFTER_DRAIN) { E(acc, cur, wr, wc, fr, fq); S.done(cur); }
        if (!has_next) break;
#pragma unroll
        for (int a = 0; a < 2; ++a)
#pragma unroll
            for (int b = 0; b < 2; ++b)
#pragma unroll
                for (int m = 0; m < 4; ++m)
#pragma unroll
                    for (int n = 0; n < 2; ++n) acc[a][b][m][n] = (f32x4){0.f, 0.f, 0.f, 0.f};
        cur = nxt; cA = nA; cB = nB; ++ui;
        if constexpr (ALIGN_EPI) { if (wr == 1) PG8_BAR; }
    }
    PG8_WAIT_V(0);
    if constexpr (!ALIGN_EPI) { if (wr == 0) PG8_BAR; }
    PG8_BAR;
    if constexpr (Epi::AFTER_DRAIN) { E.fused(acc, cur, wr, wc, fr, fq, lds, wid, lane); S.done(cur); }
#undef PG8_SA
#undef PG8_SB
#undef PG8_STAGE
#undef PG8_LDA
#undef PG8_LDB
#undef PG8_MMA
#undef PG8_WAIT_V
#undef PG8_WAIT_L
#undef PG8_BAR
#undef PG8_SCHED
}
}
constexpr int BATCH = 8, SEQ = 4096, T = BATCH * SEQ, D = 1024, FF = 4096, AW = 2048, NGRP = 8, GDIM = 256, CHUNK = 128;
constexpr int NH = 16, NKV = 4, HD = 64, KVD = NKV * HD;
constexpr float EPS = 1e-6f;
constexpr float LOG2E = 1.4426950408889634f;
constexpr float QSCALE = 0.125f * LOG2E;

namespace pg8 {
typedef short s16x4 __attribute__((ext_vector_type(4)));
__device__ __forceinline__ void row_rstd(float (&rs)[2][4], const float* ssq, int row0, int fq, float mul) {
#pragma unroll
    for (int ai = 0; ai < 2; ++ai)
#pragma unroll
        for (int m = 0; m < 4; ++m) {
            const f32x4 p = *(const f32x4*)(ssq + (size_t)(row0 + ai * HALF + m * 16) * 16 + 4 * fq);
            float s = (p[0] + p[1]) + (p[2] + p[3]);
            s += __shfl_xor(s, 16); s += __shfl_xor(s, 32);
            rs[ai][m] = mul * (1.0f / sqrtf(s * (1.0f / 1024.0f) + 1e-6f));
        }
}
template <int ACT> struct EpiRowAct {
    static constexpr bool PERM = true, AFTER_DRAIN = false;
    bf16_t* O; int ldc; const float* ssq; float sc;
    __device__ __forceinline__ void operator()(const f32x4 (&acc)[2][2][4][2], const Unit& u, int wr, int wc, int fr, int fq) const {
        const int row0 = u.pm * BM + wr * 64 + fr, col0 = u.pn * BM + wc * 32 + 8 * fq;
        float rs[2][4]; row_rstd(rs, ssq, row0, fq, sc);
#pragma unroll
        for (int ai = 0; ai < 2; ++ai)
#pragma unroll
            for (int m = 0; m < 4; ++m) { bf16_t* rowp = O + (size_t)(row0 + ai * HALF + m * 16) * ldc + col0; const float r = rs[ai][m];
#pragma unroll
                for (int bj = 0; bj < 2; ++bj) { f32x4 v0 = acc[ai][bj][m][0] * r, v1 = acc[ai][bj][m][1] * r;
                    if (ACT == 1) { f32x2 a = gelu_pk((f32x2){v0[0], v0[1]}), b = gelu_pk((f32x2){v0[2], v0[3]}), c = gelu_pk((f32x2){v1[0], v1[1]}), d = gelu_pk((f32x2){v1[2], v1[3]});
                        v0 = (f32x4){a.x, a.y, b.x, b.y}; v1 = (f32x4){c.x, c.y, d.x, d.y}; }
                    if (ACT == 2) {
#pragma unroll
                        for (int e = 0; e < 4; ++e) { const float a = fmaxf(v0[e], 0.f), b = fmaxf(v1[e], 0.f); v0[e] = a * a; v1[e] = b * b; } }
                    u32x4 w; w.x = cvt_pk_bf16(v0[0], v0[1]); w.y = cvt_pk_bf16(v0[2], v0[3]); w.z = cvt_pk_bf16(v1[0], v1[1]); w.w = cvt_pk_bf16(v1[2], v1[3]);
                    *(u32x4*)(rowp + bj * HALF) = w; } }
    }
};
template <int ACT, bool STATS> struct EpiColAct {
    static constexpr bool PERM = true, AFTER_DRAIN = false;
    bf16_t* O; int ldc; const float* ssq; float* vsum; float* vsq;
    __device__ __forceinline__ void operator()(const f32x4 (&acc)[2][2][4][2], const Unit& u, int wr, int wc, int fr, int fq) const {
        const int row0 = u.pm * BM + wr * 64 + fr, col0 = u.pn * BM + wc * 32 + 8 * fq;
        float cs[2][8];
#pragma unroll
        for (int bj = 0; bj < 2; ++bj)
#pragma unroll
            for (int j = 0; j < 8; ++j) { float s = ssq[(size_t)(col0 + bj * HALF + j) * 16 + fr];
                s += __shfl_xor(s, 1); s += __shfl_xor(s, 2); s += __shfl_xor(s, 4); s += __shfl_xor(s, 8);
                cs[bj][j] = 1.0f / sqrtf(s * (1.0f / 1024.0f) + 1e-6f); }
        float psum[2][8], psq[2][8];
#pragma unroll
        for (int bj = 0; bj < 2; ++bj)
#pragma unroll
            for (int j = 0; j < 8; ++j) { psum[bj][j] = 0.f; psq[bj][j] = 0.f; }
#pragma unroll
        for (int ai = 0; ai < 2; ++ai)
#pragma unroll
            for (int m = 0; m < 4; ++m) { bf16_t* rowp = O + (size_t)(row0 + ai * HALF + m * 16) * ldc + col0;
#pragma unroll
                for (int bj = 0; bj < 2; ++bj) { f32x4 v0 = acc[ai][bj][m][0], v1 = acc[ai][bj][m][1];
#pragma unroll
                    for (int e = 0; e < 4; ++e) { v0[e] *= cs[bj][e]; v1[e] *= cs[bj][4 + e]; }
                    if (ACT == 1) { f32x2 a = gelu_pk((f32x2){v0[0], v0[1]}), b = gelu_pk((f32x2){v0[2], v0[3]}), c = gelu_pk((f32x2){v1[0], v1[1]}), d = gelu_pk((f32x2){v1[2], v1[3]});
                        v0 = (f32x4){a.x, a.y, b.x, b.y}; v1 = (f32x4){c.x, c.y, d.x, d.y}; }
                    if (STATS) {
#pragma unroll
                        for (int e = 0; e < 4; ++e) { psum[bj][e] += v0[e]; psq[bj][e] += v0[e] * v0[e]; psum[bj][4 + e] += v1[e]; psq[bj][4 + e] += v1[e] * v1[e]; } }
                    u32x4 w; w.x = cvt_pk_bf16(v0[0], v0[1]); w.y = cvt_pk_bf16(v0[2], v0[3]); w.z = cvt_pk_bf16(v1[0], v1[1]); w.w = cvt_pk_bf16(v1[2], v1[3]);
                    *(u32x4*)(rowp + bj * HALF) = w; } }
        if (STATS) {
#pragma unroll
            for (int bj = 0; bj < 2; ++bj)
#pragma unroll
                for (int j = 0; j < 8; ++j) { float s = psum[bj][j], q = psq[bj][j];
                    s += __shfl_xor(s, 1); s += __shfl_xor(s, 2); s += __shfl_xor(s, 4); s += __shfl_xor(s, 8);
                    q += __shfl_xor(q, 1); q += __shfl_xor(q, 2); q += __shfl_xor(q, 4); q += __shfl_xor(q, 8);
                    if (fr == 0) { const size_t si = (size_t)(col0 + bj * HALF + j) * 16 + u.pm * 2 + wr; vsum[si] = s; vsq[si] = q; } }
        }
    }
};
struct EpiResid {
    static constexpr bool PERM = true, AFTER_DRAIN = false;
    const float* base; float* out; bf16_t* hbf; float* ssq;
    __device__ __forceinline__ void operator()(const f32x4 (&acc)[2][2][4][2], const Unit& u, int wr, int wc, int fr, int fq) const {
        const int row0 = u.pm * BM + wr * 64 + fr, col0 = u.pn * BM + wc * 32 + 8 * fq;
#pragma unroll
        for (int ai = 0; ai < 2; ++ai)
#pragma unroll
            for (int m = 0; m < 4; ++m) { const int row = row0 + ai * HALF + m * 16; const size_t off = (size_t)row * 1024 + col0; float q = 0.f;
#pragma unroll
                for (int bj = 0; bj < 2; ++bj) {
                    const f32x4 b0 = *(const f32x4*)(base + off + bj * HALF), b1 = *(const f32x4*)(base + off + bj * HALF + 4);
                    const f32x4 v0 = acc[ai][bj][m][0] + b0, v1 = acc[ai][bj][m][1] + b1;
                    *(f32x4*)(out + off + bj * HALF) = v0; *(f32x4*)(out + off + bj * HALF + 4) = v1;
                    u32x4 w; w.x = cvt_pk_bf16(v0[0], v0[1]); w.y = cvt_pk_bf16(v0[2], v0[3]); w.z = cvt_pk_bf16(v1[0], v1[1]); w.w = cvt_pk_bf16(v1[2], v1[3]);
                    *(u32x4*)(hbf + off + bj * HALF) = w;
                    q += (v0[0] * v0[0] + v0[1] * v0[1]) + (v0[2] * v0[2] + v0[3] * v0[3]) + (v1[0] * v1[0] + v1[1] * v1[1]) + (v1[2] * v1[2] + v1[3] * v1[3]); }
                q += __shfl_xor(q, 16); q += __shfl_xor(q, 32);
                if (fq == 0) ssq[(size_t)row * 16 + u.pn * 4 + wc] = q; }
    }
};
}

constexpr size_t MiB = 1u << 20;
constexpr size_t WS_WIN = 0, WS_WOUT = 16 * MiB, WS_W1 = 24 * MiB, WS_W2 = 56 * MiB, WS_WQ = 88 * MiB, WS_WO = 92 * MiB, WS_WKV = 96 * MiB, WS_WC = 97 * MiB, WS_BIAS = 98 * MiB;
constexpr size_t WS_SSQ = 100 * MiB, WS_VSUM = 102 * MiB, WS_VSQ = 104 * MiB, WS_HBF = 112 * MiB, WS_K = 176 * MiB, WS_VT = 192 * MiB, WS_R1 = 208 * MiB, WS_END = 464 * MiB;
constexpr int LDS_BYTES = 135168;
constexpr int NTHREADS = 512;

#define LAS __attribute__((address_space(3)))
typedef unsigned short bf16;
typedef unsigned u32x4 __attribute__((ext_vector_type(4)));
typedef unsigned u32x2 __attribute__((ext_vector_type(2)));
typedef float f32x4 __attribute__((ext_vector_type(4)));
typedef short bf16x8 __attribute__((ext_vector_type(8)));
typedef short s16x4 __attribute__((ext_vector_type(4)));

__device__ __forceinline__ unsigned pk2(float lo, float hi) { return pg8::cvt_pk_bf16(lo, hi); }
__device__ __forceinline__ float bf_lo(unsigned w) { return __uint_as_float(w << 16); }
__device__ __forceinline__ float bf_hi(unsigned w) { return __uint_as_float(w & 0xffff0000u); }
__device__ __forceinline__ float wave_sum(float v) {
#pragma unroll
    for (int o = 1; o < 64; o <<= 1) v += __shfl_xor(v, o);
    return v;
}

__device__ __forceinline__ void transpose_item(const float* W, int K, int N, const float* g, bf16* WT, LAS float* scr, int item, int lane) {
    const int nblk = N / 32, kb = item / nblk, nb = item % nblk, k0 = 64 * kb, n0 = 32 * nb;
#pragma unroll 8
    for (int i = 0; i < 32; ++i) { const int kk = 2 * i + (lane >> 5); float w = W[(size_t)(k0 + kk) * N + n0 + (lane & 31)]; if (g) w *= g[k0 + kk]; scr[kk * 33 + (lane & 31)] = w; }
    asm volatile("s_waitcnt lgkmcnt(0)" ::: "memory");
    const int c = lane & 7;
#pragma unroll
    for (int j = 0; j < 4; ++j) { const int n = (lane >> 3) + 8 * j; const LAS float* s = scr + (8 * c) * 33 + n;
        u32x4 o; o.x = pk2(s[0 * 33], s[1 * 33]); o.y = pk2(s[2 * 33], s[3 * 33]); o.z = pk2(s[4 * 33], s[5 * 33]); o.w = pk2(s[6 * 33], s[7 * 33]);
        *(u32x4*)(WT + (size_t)(n0 + n) * K + k0 + 8 * c) = o; }
    asm volatile("s_waitcnt lgkmcnt(0)" ::: "memory");
}

struct Args {
    const float* x; const float* mix_g; const float* ffn_g; const float* a_w_in; const float* a_ln_g; const float* a_w_s; const float* a_b_s; const float* a_w_out;
    const float* kv_g; const float* w_k; const float* w_v; const float* b_w_q; const float* b_sinks; const float* b_w_o; const float* rel_bias; const float* ffn_w1; const float* ffn_w2; const float* final_g;
    float* out; unsigned char* ws;
};

__device__ __forceinline__ void prologue(const Args& a, LAS unsigned char* lds) {
    const int tid = opaque_tid(), lane = tid & 63, wave = tid >> 6;
    LAS float* scr = (LAS float*)(lds + wave * 16384);
    const int gw = blockIdx.x * 8 + wave, NGW = gridDim.x * 8;
    unsigned char* ws = a.ws;
    constexpr int I_IN = (D / 64) * (4096 / 32), I_OUT = (AW / 64) * (D / 32), I_1 = (D / 64) * (FF / 32), I_2 = (FF / 64) * (D / 32), I_Q = (D / 64) * (D / 32), I_KV = (D / 64) * (KVD / 32);
    constexpr int NITEMS = 2 * I_IN + 2 * I_OUT + 4 * I_1 + 4 * I_2 + 2 * I_Q + 2 * I_Q + 2 * I_KV;
    for (int it = gw; it < NITEMS; it += NGW) {
        int r = it;
#define TR(CNT, W, Kd, Nd, G, DST) if (r < (CNT)) { transpose_item((W), (Kd), (Nd), (G), (bf16*)(DST), scr, r, lane); continue; } r -= (CNT);
        TR(I_IN, a.a_w_in, D, 4096, a.mix_g, ws + WS_WIN)
        TR(I_IN, a.a_w_in + (size_t)D * 4096, D, 4096, a.mix_g + D, ws + WS_WIN + (size_t)D * 4096 * 2)
        TR(I_OUT, a.a_w_out, AW, D, nullptr, ws + WS_WOUT)
        TR(I_OUT, a.a_w_out + (size_t)AW * D, AW, D, nullptr, ws + WS_WOUT + (size_t)AW * D * 2)
        TR(I_1, a.ffn_w1 + 0 * (size_t)D * FF, D, FF, a.ffn_g + 0 * D, ws + WS_W1 + 0 * (size_t)D * FF * 2)
        TR(I_1, a.ffn_w1 + 1 * (size_t)D * FF, D, FF, a.ffn_g + 1 * D, ws + WS_W1 + 1 * (size_t)D * FF * 2)
        TR(I_1, a.ffn_w1 + 2 * (size_t)D * FF, D, FF, a.ffn_g + 2 * D, ws + WS_W1 + 2 * (size_t)D * FF * 2)
        TR(I_1, a.ffn_w1 + 3 * (size_t)D * FF, D, FF, a.ffn_g + 3 * D, ws + WS_W1 + 3 * (size_t)D * FF * 2)
        TR(I_2, a.ffn_w2 + 0 * (size_t)D * FF, FF, D, nullptr, ws + WS_W2 + 0 * (size_t)D * FF * 2)
        TR(I_2, a.ffn_w2 + 1 * (size_t)D * FF, FF, D, nullptr, ws + WS_W2 + 1 * (size_t)D * FF * 2)
        TR(I_2, a.ffn_w2 + 2 * (size_t)D * FF, FF, D, nullptr, ws + WS_W2 + 2 * (size_t)D * FF * 2)
        TR(I_2, a.ffn_w2 + 3 * (size_t)D * FF, FF, D, nullptr, ws + WS_W2 + 3 * (size_t)D * FF * 2)
        TR(I_Q, a.b_w_q, D, D, a.mix_g + 2 * D, ws + WS_WQ)
        TR(I_Q, a.b_w_q + (size_t)D * D, D, D, a.mix_g + 3 * D, ws + WS_WQ + (size_t)D * D * 2)
        TR(I_Q, a.b_w_o, D, D, nullptr, ws + WS_WO)
        TR(I_Q, a.b_w_o + (size_t)D * D, D, D, nullptr, ws + WS_WO + (size_t)D * D * 2)
        TR(I_KV, a.w_k, D, KVD, a.kv_g, ws + WS_WKV)
        TR(I_KV, a.w_v, D, KVD, a.kv_g, ws + WS_WKV + (size_t)D * KVD * 2)
#undef TR
    }
    {
        bf16* wc = (bf16*)(ws + WS_WC);
        const int gt = blockIdx.x * NTHREADS + tid, NT = gridDim.x * NTHREADS;
        for (int i = gt; i < 2 * NGRP * CHUNK * CHUNK / 2; i += NT) {
            const int e = 2 * i, col = e & 127, row = (e >> 7) & 127;
            const float w0 = (col <= row) ? a.a_w_s[e] : 0.f, w1 = (col + 1 <= row) ? a.a_w_s[e + 1] : 0.f;
            ((unsigned*)wc)[i] = pk2(w0, w1);
        }
        float* b2 = (float*)(ws + WS_BIAS);
        for (int i = gt; i < NH * 128; i += NT) {
            const int h = i >> 7, d = i & 127; int bucket;
            if (d < 16) bucket = d;
            else { const float lr = logf((float)d / 16.0f) / logf(8.0f); int l = 16 + (int)(lr * 16.0f); bucket = l < 31 ? l : 31; }
            b2[i] = a.rel_bias[bucket * NH + h] * LOG2E;
        }
    }
    {
        bf16* hbf = (bf16*)(ws + WS_HBF); float* ssq = (float*)(ws + WS_SSQ);
        for (int m = gw; m < T; m += NGW) {
            const f32x4* xr = (const f32x4*)(a.x + (size_t)m * D) + lane; f32x4 v[4]; float s = 0.f;
#pragma unroll
            for (int j = 0; j < 4; ++j) { v[j] = xr[64 * j]; s += (v[j][0] * v[j][0] + v[j][1] * v[j][1]) + (v[j][2] * v[j][2] + v[j][3] * v[j][3]); }
            s = wave_sum(s);
            u32x2* o8 = (u32x2*)(hbf + (size_t)m * D) + lane;
#pragma unroll
            for (int j = 0; j < 4; ++j) { u32x2 w; w.x = pk2(v[j][0], v[j][1]); w.y = pk2(v[j][2], v[j][3]); o8[64 * j] = w; }
            if (lane < 16) ssq[(size_t)m * 16 + lane] = (lane == 0) ? s : 0.f;
        }
    }
}

__device__ __forceinline__ void sgu_phase(LAS unsigned char* lds, const bf16* WcBf, const float* lng, const float* bs, const bf16* vT, bf16* u, const float* vsum, const float* vsq) {
    const int tid = opaque_tid(), wid = tid >> 6, lane = tid & 63, fr = lane & 15, fq = lane >> 4, wr = wid >> 2, wc = wid & 3;
    LAS unsigned char* As = lds;
    LAS unsigned char* Bs = lds + 34816;
    LAS float* MU = (LAS float*)(lds + 34816 + 69632); LAS float* RS = MU + 128;
    for (int unit = blockIdx.x; unit < (T / CHUNK) * NGRP; unit += gridDim.x) {
        const int n = unit >> 3, g = unit & 7, tok0 = n * CHUNK;
        if (tid < 128) {
            const f32x4* ps = (const f32x4*)(vsum + (size_t)(tok0 + tid) * 16); const f32x4* pq = (const f32x4*)(vsq + (size_t)(tok0 + tid) * 16); float s = 0.f, q = 0.f;
#pragma unroll
            for (int i = 0; i < 4; ++i) { const f32x4 a = ps[i], b = pq[i]; s += (a[0] + a[1]) + (a[2] + a[3]); q += (b[0] + b[1]) + (b[2] + b[3]); }
            const float mean = s * (1.0f / 2048.0f); float var = q * (1.0f / 2048.0f) - mean * mean; var = var > 0.f ? var : 0.f;
            MU[tid] = mean; RS[tid] = 1.0f / sqrtf(var + EPS);
        }
        const bf16* Ag = WcBf + (size_t)g * CHUNK * CHUNK;
#pragma unroll
        for (int i = 0; i < 4; ++i) { const int q = tid + 512 * i, r = q >> 4, c8 = (q & 15) * 8; const u32x4 v = *(const u32x4*)(Ag + r * 128 + c8); *(LAS u32x4*)(As + r * 272 + c8 * 2) = v; }
        __syncthreads();
        {
            const int jc = (tid & 15) * 8; float mu[8], rs[8];
#pragma unroll
            for (int j = 0; j < 8; ++j) { mu[j] = MU[jc + j]; rs[j] = RS[jc + j]; }
#pragma unroll
            for (int i = 0; i < 8; ++i) { const int q = tid + 512 * i, r = q >> 4, chan = g * GDIM + r;
                const u32x4 raw = *(const u32x4*)(vT + (size_t)chan * T + tok0 + jc); const float gc = lng[chan];
                float y[8]; y[0] = bf_lo(raw.x); y[1] = bf_hi(raw.x); y[2] = bf_lo(raw.y); y[3] = bf_hi(raw.y); y[4] = bf_lo(raw.z); y[5] = bf_hi(raw.z); y[6] = bf_lo(raw.w); y[7] = bf_hi(raw.w);
#pragma unroll
                for (int j = 0; j < 8; ++j) y[j] = (y[j] - mu[j]) * rs[j] * gc;
                u32x4 w; w.x = pk2(y[0], y[1]); w.y = pk2(y[2], y[3]); w.z = pk2(y[4], y[5]); w.w = pk2(y[6], y[7]);
                const int pos = (r & ~31) + 16 * ((r >> 2) & 1) + 4 * ((r >> 3) & 3) + (r & 3);
                *(LAS u32x4*)(Bs + pos * 272 + jc * 2) = w; }
        }
        __syncthreads();
        f32x4 acc[4][4];
#pragma unroll
        for (int m = 0; m < 4; ++m)
#pragma unroll
            for (int nn = 0; nn < 4; ++nn) acc[m][nn] = (f32x4){0.f, 0.f, 0.f, 0.f};
        const int nk = wr ? 4 : 2;
        for (int kk = 0; kk < nk; ++kk) {
            bf16x8 af[4], bfr[4];
#pragma unroll
            for (int m = 0; m < 4; ++m) af[m] = *(const LAS bf16x8*)(As + (64 * wr + 16 * m + fr) * 272 + kk * 64 + fq * 16);
#pragma unroll
            for (int nn = 0; nn < 4; ++nn) bfr[nn] = *(const LAS bf16x8*)(Bs + (64 * wc + 16 * nn + fr) * 272 + kk * 64 + fq * 16);
#pragma unroll
            for (int m = 0; m < 4; ++m)
#pragma unroll
                for (int nn = 0; nn < 4; ++nn) acc[m][nn] = __builtin_amdgcn_mfma_f32_16x16x32_bf16(bfr[nn], af[m], acc[m][nn], 0, 0, 0);
        }
#pragma unroll
        for (int m = 0; m < 4; ++m) { const int i = 64 * wr + 16 * m + fr; const float bi = bs[g * CHUNK + i];
#pragma unroll
            for (int p = 0; p < 2; ++p) { bf16* up = u + (size_t)(tok0 + i) * AW + g * GDIM + 64 * wc + 32 * p + 8 * fq;
                const u32x4 uv = *(const u32x4*)up; const f32x4 a0 = acc[m][2 * p], a1 = acc[m][2 * p + 1];
                u32x4 w;
                w.x = pk2(bf_lo(uv.x) * (a0[0] + bi), bf_hi(uv.x) * (a0[1] + bi)); w.y = pk2(bf_lo(uv.y) * (a0[2] + bi), bf_hi(uv.y) * (a0[3] + bi));
                w.z = pk2(bf_lo(uv.z) * (a1[0] + bi), bf_hi(uv.z) * (a1[1] + bi)); w.w = pk2(bf_lo(uv.w) * (a1[2] + bi), bf_hi(uv.w) * (a1[3] + bi));
                *(u32x4*)up = w; } }
        __syncthreads();
    }
}

__device__ __forceinline__ void attn_phase(LAS unsigned char* lds, const bf16* Q, const bf16* Kb, const bf16* VT, bf16* O, const float* bias2, const float* sinks) {
    const int tid = opaque_tid(), wid = tid >> 6, lane = tid & 63, fr = lane & 15, fq = lane >> 4;
    LAS unsigned char* Ks = lds;
    LAS unsigned char* Vs = lds + 36864;
    LAS float* Bt = (LAS float*)(lds + 36864 + 33792);
    for (int unit = blockIdx.x; unit < BATCH * (SEQ / 128) * NKV; unit += gridDim.x) {
        const int kh = unit & 3, nb = (unit >> 2) & 31, b = unit >> 7, tok0 = b * SEQ + nb * 128, kt0 = tok0 - 128;
#pragma unroll
        for (int i = 0; i < 4; ++i) { const int q = tid + 512 * i, r = q >> 3, c8 = (q & 7) * 8; u32x4 v = (u32x4){0u, 0u, 0u, 0u};
            if (nb > 0 || r >= 128) v = *(const u32x4*)(Kb + (size_t)(kt0 + r) * KVD + kh * HD + c8);
            *(LAS u32x4*)(Ks + r * 144 + c8 * 2) = v; }
#pragma unroll
        for (int i = 0; i < 4; ++i) { const int q = tid + 512 * i, r = q >> 5, c8 = (q & 31) * 8; u32x4 v = (u32x4){0u, 0u, 0u, 0u};
            if (nb > 0 || c8 >= 128) v = *(const u32x4*)(VT + (size_t)(kh * HD + r) * T + kt0 + c8);
            *(LAS u32x4*)(Vs + r * 528 + c8 * 2) = v; }
        Bt[tid] = bias2[(kh * 4 + (tid >> 7)) * 128 + (tid & 127)];
        __syncthreads();
        const int hq = kh * 4 + (wid >> 1); const float sink2 = sinks[hq] * LOG2E;
        const LAS float* bt = Bt + (wid >> 1) * 128;
        for (int grp = 0; grp < 4; ++grp) {
            const int q0 = 64 * (wid & 1) + 16 * grp, tl = q0 >> 4;
            bf16x8 yq[2];
#pragma unroll
            for (int kk = 0; kk < 2; ++kk) yq[kk] = *(const bf16x8*)(Q + (size_t)(tok0 + q0 + fr) * D + hq * HD + kk * 32 + fq * 8);
            f32x4 S[9];
#pragma unroll
            for (int t = 0; t < 9; ++t) { S[t] = (f32x4){0.f, 0.f, 0.f, 0.f};
#pragma unroll
                for (int kk = 0; kk < 2; ++kk) { const bf16x8 xk = *(const LAS bf16x8*)(Ks + (16 * (tl + t) + fr) * 144 + kk * 64 + fq * 16);
                    S[t] = __builtin_amdgcn_mfma_f32_16x16x32_bf16(xk, yq[kk], S[t], 0, 0, 0); } }
            float mx = sink2;
#pragma unroll
            for (int t = 0; t < 9; ++t)
#pragma unroll
                for (int e = 0; e < 4; ++e) { const int dist = fr + 128 - 16 * t - 4 * fq - e, kj = 16 * (tl + t) + 4 * fq + e;
                    const bool valid = (dist >= 0) && (dist < 128) && (nb > 0 || kj >= 128);
                    const float l2 = valid ? S[t][e] + bt[dist & 127] : -1e30f; S[t][e] = l2; mx = fmaxf(mx, l2); }
            mx = fmaxf(mx, __shfl_xor(mx, 16)); mx = fmaxf(mx, __shfl_xor(mx, 32));
            float l = 0.f;
#pragma unroll
            for (int t = 0; t < 9; ++t)
#pragma unroll
                for (int e = 0; e < 4; ++e) { const float p = __builtin_amdgcn_exp2f(S[t][e] - mx); S[t][e] = p; l += p; }
            l += __shfl_xor(l, 16); l += __shfl_xor(l, 32); l += __builtin_amdgcn_exp2f(sink2 - mx);
            bf16x8 yp[5];
#pragma unroll
            for (int pp = 0; pp < 5; ++pp) { const f32x4 lo = S[2 * pp]; const f32x4 hi = (2 * pp + 1 < 9) ? S[(2 * pp + 1 < 9) ? 2 * pp + 1 : 8] : (f32x4){0.f, 0.f, 0.f, 0.f};
                u32x4 w; w.x = pk2(lo[0], lo[1]); w.y = pk2(lo[2], lo[3]); w.z = pk2(hi[0], hi[1]); w.w = pk2(hi[2], hi[3]); yp[pp] = __builtin_bit_cast(bf16x8, w); }
            f32x4 Oa[4];
#pragma unroll
            for (int dt = 0; dt < 4; ++dt) { Oa[dt] = (f32x4){0.f, 0.f, 0.f, 0.f};
#pragma unroll
                for (int pp = 0; pp < 5; ++pp) { const int ta = tl + 2 * pp, tb = (2 * pp + 1 < 9) ? ta + 1 : ta;
                    const s16x4 va = *(const LAS s16x4*)(Vs + (16 * dt + fr) * 528 + (16 * ta + 4 * fq) * 2), vb = *(const LAS s16x4*)(Vs + (16 * dt + fr) * 528 + (16 * tb + 4 * fq) * 2);
                    const bf16x8 xv = (bf16x8){va[0], va[1], va[2], va[3], vb[0], vb[1], vb[2], vb[3]};
                    Oa[dt] = __builtin_amdgcn_mfma_f32_16x16x32_bf16(xv, yp[pp], Oa[dt], 0, 0, 0); } }
            const float inv = 1.0f / l;
            bf16* op = O + (size_t)(tok0 + q0 + fr) * D + hq * HD + 4 * fq;
#pragma unroll
            for (int dt = 0; dt < 4; ++dt) { u32x2 w; w.x = pk2(Oa[dt][0] * inv, Oa[dt][1] * inv); w.y = pk2(Oa[dt][2] * inv, Oa[dt][3] * inv); *(u32x2*)(op + 16 * dt) = w; }
        }
        __syncthreads();
    }
}

__device__ __forceinline__ void final_norm(float* out, const float* ssq, const float* g) {
    const int tid = opaque_tid(), lane = tid & 63, wave = tid >> 6;
    const int gw = blockIdx.x * 8 + wave, NGW = gridDim.x * 8;
    f32x4 gv[4];
#pragma unroll
    for (int j = 0; j < 4; ++j) gv[j] = ((const f32x4*)g)[lane + 64 * j];
    for (int m = gw; m < T; m += NGW) {
        float s = ssq[(size_t)m * 16 + (lane & 15)];
        s += __shfl_xor(s, 1); s += __shfl_xor(s, 2); s += __shfl_xor(s, 4); s += __shfl_xor(s, 8);
        const float r = 1.0f / sqrtf(s * (1.0f / 1024.0f) + EPS);
        f32x4* xr = (f32x4*)(out + (size_t)m * D) + lane;
#pragma unroll
        for (int j = 0; j < 4; ++j) { f32x4 v = xr[64 * j]; v = v * r * gv[j]; xr[64 * j] = v; }
    }
}

#ifndef PHASE_MASK
#define PHASE_MASK 0xFFFF
#endif
#define PH(b) if constexpr ((PHASE_MASK >> (b)) & 1)
__global__ void __launch_bounds__(NTHREADS, 2) fwd_megakernel(Args a) {
    extern __shared__ __attribute__((aligned(16))) unsigned char lds_raw[];
    LAS unsigned char* lds = (LAS unsigned char*)lds_raw;
    cg::grid_group grid = cg::this_grid();
    unsigned char* ws = a.ws;
    const int G = gridDim.x, c = blockIdx.x;
    bf16* hbf = (bf16*)(ws + WS_HBF); float* ssq = (float*)(ws + WS_SSQ); float* vsum = (float*)(ws + WS_VSUM); float* vsq = (float*)(ws + WS_VSQ);
    bf16* R1 = (bf16*)(ws + WS_R1);

    PH(0) prologue(a, lds);
    grid.sync();

    for (int layer = 0; layer < 4; ++layer) {
        const bf16* mixA; const bf16* mixW; int mixK;
        if (layer < 2) {
            const bf16* Win = (const bf16*)(ws + WS_WIN) + (size_t)layer * 4096 * D;
            bf16* U = R1; bf16* VTt = R1 + (size_t)T * AW;
            PH(1) {
                pg8::Gemm g{hbf, Win, T, AW, D}; pg8::StaticOrder S; S.init(T, AW, G, c);
                pg8::EpiRowAct<1> E{U, AW, ssq, 1.0f};
                pg8::gemm_phase<pg8::EpiRowAct<1>, pg8::StaticOrder, true, true>(lds, g, S, E);
            }
            PH(2) {
                pg8::Gemm g{Win + (size_t)AW * D, hbf, AW, T, D}; pg8::StaticOrder S; S.init(AW, T, G, c);
                pg8::EpiColAct<1, true> E{VTt, T, ssq, vsum, vsq};
                pg8::gemm_phase<pg8::EpiColAct<1, true>, pg8::StaticOrder, true, true>(lds, g, S, E);
            }
            grid.sync();
            PH(3) sgu_phase(lds, (const bf16*)(ws + WS_WC) + (size_t)layer * NGRP * CHUNK * CHUNK, a.a_ln_g + (size_t)layer * AW, a.a_b_s + (size_t)layer * NGRP * CHUNK, VTt, U, vsum, vsq);
            grid.sync();
            mixA = U; mixW = (const bf16*)(ws + WS_WOUT) + (size_t)layer * D * AW; mixK = AW;
        } else {
            const int j = layer - 2;
            bf16* Qb = R1; bf16* Ob = R1 + (size_t)T * D; bf16* Kb = (bf16*)(ws + WS_K); bf16* VTb = (bf16*)(ws + WS_VT);
            PH(4) {
                pg8::Gemm g{hbf, (const bf16*)(ws + WS_WQ) + (size_t)j * D * D, T, D, D}; pg8::StaticOrder S; S.init(T, D, G, c);
                pg8::EpiRowAct<0> E{Qb, D, ssq, QSCALE};
                pg8::gemm_phase<pg8::EpiRowAct<0>, pg8::StaticOrder, true, true>(lds, g, S, E);
            }
            if (layer == 2) {
                PH(5) {
                    pg8::Gemm g{hbf, (const bf16*)(ws + WS_WKV), T, KVD, D}; pg8::StaticOrder S; S.init(T, KVD, G, c);
                    pg8::EpiRowAct<0> E{Kb, KVD, ssq, 1.0f};
                    pg8::gemm_phase<pg8::EpiRowAct<0>, pg8::StaticOrder, true, true>(lds, g, S, E);
                }
                PH(6) {
                    pg8::Gemm g{(const bf16*)(ws + WS_WKV) + (size_t)D * KVD, hbf, KVD, T, D}; pg8::StaticOrder S; S.init(KVD, T, G, (c + G / 2) % G);
                    pg8::EpiColAct<0, false> E{VTb, T, ssq, nullptr, nullptr};
                    pg8::gemm_phase<pg8::EpiColAct<0, false>, pg8::StaticOrder, true, true>(lds, g, S, E);
                }
            }
            grid.sync();
            PH(7) attn_phase(lds, Qb, Kb, VTb, Ob, (const float*)(ws + WS_BIAS), a.b_sinks + j * NH);
            grid.sync();
            mixA = Ob; mixW = (const bf16*)(ws + WS_WO) + (size_t)j * D * D; mixK = D;
        }
        PH(8) {
            pg8::Gemm g{mixA, mixW, T, D, mixK}; pg8::StaticOrder S; S.init(T, D, G, c);
            pg8::EpiResid E{layer == 0 ? a.x : a.out, a.out, hbf, ssq};
            pg8::gemm_phase<pg8::EpiResid, pg8::StaticOrder, true, true>(lds, g, S, E);
        }
        grid.sync();
        bf16* Fb = R1;
        PH(9) {
            pg8::Gemm g{hbf, (const bf16*)(ws + WS_W1) + (size_t)layer * D * FF, T, FF, D}; pg8::StaticOrder S; S.init(T, FF, G, c);
            pg8::EpiRowAct<2> E{Fb, FF, ssq, 1.0f};
            pg8::gemm_phase<pg8::EpiRowAct<2>, pg8::StaticOrder, true, true>(lds, g, S, E);
        }
        grid.sync();
        PH(10) {
            pg8::Gemm g{Fb, (const bf16*)(ws + WS_W2) + (size_t)layer * D * FF, T, D, FF}; pg8::StaticOrder S; S.init(T, D, G, c);
            pg8::EpiResid E{a.out, a.out, hbf, ssq};
            pg8::gemm_phase<pg8::EpiResid, pg8::StaticOrder, true, true>(lds, g, S, E);
        }
        grid.sync();
    }
    PH(11) final_norm(a.out, ssq, a.final_g);
}

extern "C" void kernel_launch(void* const* d_in, const int* in_sizes, int n_in, void* d_out, int out_size, void* d_ws, size_t ws_size, hipStream_t stream) {
    static int grid = 0;
    if (grid == 0) {
        if (n_in != 18 || in_sizes[0] != T * D || out_size != T * D || ws_size < WS_END) { fprintf(stderr, "kernel_launch: unexpected shapes (n_in %d in0 %d out %d ws %zu)\n", n_in, n_in > 0 ? in_sizes[0] : -1, out_size, ws_size); grid = -1; return; }
        int dev = 0, cus = 0, per_cu = 0;
        hipGetDevice(&dev); hipDeviceGetAttribute(&cus, hipDeviceAttributeMultiprocessorCount, dev);
        if (hipFuncSetAttribute((const void*)fwd_megakernel, hipFuncAttributeMaxDynamicSharedMemorySize, LDS_BYTES) != hipSuccess) { fprintf(stderr, "kernel_launch: hipFuncSetAttribute failed\n"); grid = -1; return; }
        if (hipOccupancyMaxActiveBlocksPerMultiprocessor(&per_cu, (const void*)fwd_megakernel, NTHREADS, LDS_BYTES) != hipSuccess || per_cu < 1) { fprintf(stderr, "kernel_launch: occupancy query says %d\n", per_cu); per_cu = 1; }
        (void)hipGetLastError();
        grid = cus * 1;
    }
    if (grid < 0) return;
    Args a{};
    a.x = (const float*)d_in[0]; a.mix_g = (const float*)d_in[1]; a.ffn_g = (const float*)d_in[2]; a.a_w_in = (const float*)d_in[3]; a.a_ln_g = (const float*)d_in[4];
    a.a_w_s = (const float*)d_in[5]; a.a_b_s = (const float*)d_in[6]; a.a_w_out = (const float*)d_in[7]; a.kv_g = (const float*)d_in[8]; a.w_k = (const float*)d_in[9];
    a.w_v = (const float*)d_in[10]; a.b_w_q = (const float*)d_in[11]; a.b_sinks = (const float*)d_in[12]; a.b_w_o = (const float*)d_in[13]; a.rel_bias = (const float*)d_in[14];
    a.ffn_w1 = (const float*)d_in[15]; a.ffn_w2 = (const float*)d_in[16]; a.final_g = (const float*)d_in[17];
    a.out = (float*)d_out; a.ws = (unsigned char*)d_ws;
    void* args[] = {&a};
    hipError_t e = hipLaunchCooperativeKernel((const void*)fwd_megakernel, dim3(grid), dim3(NTHREADS), args, LDS_BYTES, stream);
    if (e != hipSuccess) fprintf(stderr, "kernel_launch: cooperative launch failed: %s (grid %d)\n", hipGetErrorString(e), grid);
}
```

```cpp
#include <hip/hip_runtime.h>
#include <hip/hip_cooperative_groups.h>
#include <cstdio>
#include <cstdint>
namespace cg = cooperative_groups;
__device__ __forceinline__ int opaque_tid() { int t = threadIdx.x; asm volatile("" : "+v"(t)); return t; }

namespace pg8 {
#define PG8_LAS __attribute__((address_space(3)))
typedef unsigned short bf16_t;
typedef short bf16x8 __attribute__((ext_vector_type(8)));
typedef float f32x4 __attribute__((ext_vector_type(4)));
typedef unsigned u32x4 __attribute__((ext_vector_type(4)));
constexpr int BM = 256, BK = 64, HALF = 128, HTB = HALF * BK * 2  , STAGE_BYTES = 8 * HTB, NXCD = 8, WGM = 8;

__host__ __device__ __forceinline__ int lds_byte(int r, int c) { const int st = (r >> 4) * 2 + (c >> 5), rr = r & 15, cc = c & 31, ob = rr * 64 + cc * 2; return st * 1024 + (ob ^ (((ob >> 9) & 1) << 5)); }
__host__ __device__ __forceinline__ void stage_rc(int b, int& R, int& C) { const int st = b / 1024, sb = b % 1024, swz = sb ^ (((sb >> 9) & 1) << 5); R = (st >> 1) * 16 + swz / 64; C = (st & 1) * 32 + (swz % 64) / 2; }
__host__ __device__ __forceinline__ int perm32(int rho) { const int n = rho >> 4, i = rho & 15; return 8 * (i >> 2) + 4 * n + (i & 3); }

struct Unit { int pm, pn; };
struct Gemm { const bf16_t* A; const bf16_t* Bt; int M, N, K; };

struct StaticOrder {
    int nM, nN, nwg, G, c;
    __host__ __device__ void init(int M, int N, int G_, int c_) { nM = M / BM; nN = N / BM; nwg = nM * nN; G = G_; c = c_; }
    __host__ __device__ bool next(int i, Unit& u) const {
        const long L = (long)i * G + c; if (L >= nwg) return false;
        int wgid = (int)L; { const int q = nwg / NXCD, r = nwg % NXCD, xcd = wgid % NXCD, off = wgid / NXCD; wgid = (xcd < r ? xcd * (q + 1) : r * (q + 1) + (xcd - r) * q) + off; }
        const int nig = WGM * nN, gid = wgid / nig, fm = gid * WGM, gsz = (nM - fm) < WGM ? (nM - fm) : WGM;
        u.pm = fm + ((wgid % nig) % gsz); u.pn = (wgid % nig) / gsz; return true;
    }
    __device__ __forceinline__ void a_ready(const Unit&) const {}
    __device__ __forceinline__ void done(const Unit&) const {}
};
__device__ __forceinline__ unsigned cvt_pk_bf16(float lo, float hi) { unsigned r; asm volatile("v_cvt_pk_bf16_f32 %0, %1, %2" : "=v"(r) : "v"(lo), "v"(hi)); return r; }
typedef float f32x2 __attribute__((ext_vector_type(2)));
__device__ __forceinline__ f32x2 gelu_pk(f32x2 v) {
    const f32x2 av = __builtin_elementwise_abs(v), d = av * 0.2316418882f + 1.0f;
    f32x2 t; t.x = __builtin_amdgcn_rcpf(d.x); t.y = __builtin_amdgcn_rcpf(d.y);
    f32x2 q = t * 0.5307027145f + (-0.7265760135f); q = q * t + 0.7107068705f; q = q * t + (-0.142248368f); q = q * t + 0.127414796f; q = q * t;
    const f32x2 s = (v * v) * (-0.72134752044f);
    f32x2 e; e.x = __builtin_amdgcn_exp2f(s.x); e.y = __builtin_amdgcn_exp2f(s.y);
    const f32x2 m = v * (q * e), r = v - m;
    f32x2 o; o.x = v.x < 0.f ? m.x : r.x; o.y = v.y < 0.f ? m.y : r.y; return o;
}
template <class Epi, class Sched, bool ALIGN_EPI = false, bool SP2 = false>
__device__ __forceinline__ void gemm_phase(PG8_LAS unsigned char* lds, const Gemm g, const Sched& S, const Epi& E) {
    const int tid = opaque_tid(), wid = __builtin_amdgcn_readfirstlane(tid >> 6), lane = tid & 63, wr = wid >> 2, wc = wid & 3, fr = lane & 15, fq = lane >> 4;
    const int K = g.K, nt = K / BK;
    unsigned voffA[2], voffB[2];
#pragma unroll
    for (int i = 0; i < 2; ++i) { int R, C; stage_rc(tid * 16 + i * 8192, R, C); const int Rb = Epi::PERM ? ((R & ~31) + perm32(R & 31)) : R;
        voffA[i] = (unsigned)(R * K + C) * 2u; voffB[i] = (unsigned)(Rb * K + C) * 2u; }
    const size_t kstep = (size_t)(BK * 2);
    const size_t hstep = (size_t)HALF * K * 2;
    const size_t tstep = 2 * hstep;
    const unsigned ldsw = (unsigned)wid * 1024u;
    const int aoff = lds_byte(wr * 64 + fr, fq * 8), boff = lds_byte(wc * 32 + fr, fq * 8);
#define PG8_SA(b, h) (((b) * 2 + (h)) * HTB)
#define PG8_SB(b, h) ((4 + (b) * 2 + (h)) * HTB)
#define PG8_STAGE(bufoff, gbase, voff) do { _Pragma("unroll") for (int _i = 0; _i < 2; ++_i) \
        __builtin_amdgcn_global_load_lds((const unsigned*)((const char*)(gbase) + (voff)[_i]), (PG8_LAS unsigned*)(lds + (bufoff) + ldsw + _i * 8192), 16, 0, 0); } while (0)
#define PG8_LDA(dst, b, h) do { _Pragma("unroll") for (int m = 0; m < 4; ++m) _Pragma("unroll") for (int k = 0; k < 2; ++k) dst[m][k] = *(const PG8_LAS bf16x8*)(lds + PG8_SA(b, h) + aoff + m * 2048 + k * 1024); } while (0)
#define PG8_LDB(dst, b, h) do { _Pragma("unroll") for (int n = 0; n < 2; ++n) _Pragma("unroll") for (int k = 0; k < 2; ++k) dst[n][k] = *(const PG8_LAS bf16x8*)(lds + PG8_SB(b, h) + boff + n * 2048 + k * 1024); } while (0)
#define PG8_MMA(ai, bj, At, Bt) do { __builtin_amdgcn_s_setprio(1); _Pragma("unroll") for (int m = 0; m < 4; ++m) _Pragma("unroll") for (int n = 0; n < 2; ++n) _Pragma("unroll") for (int k = 0; k < 2; ++k) \
        acc[ai][bj][m][n] = __builtin_amdgcn_mfma_f32_16x16x32_bf16(Bt[n][k], At[m][k], acc[ai][bj][m][n], 0, 0, 0); __builtin_amdgcn_s_setprio(0); } while (0)
#define PG8_WAIT_V(n) asm volatile("s_waitcnt vmcnt(" #n ")" ::: "memory")
#define PG8_WAIT_L(n) asm volatile("s_waitcnt lgkmcnt(" #n ")" ::: "memory")
#define PG8_BAR __builtin_amdgcn_s_barrier()
#define PG8_SCHED __builtin_amdgcn_sched_barrier(0)
    Unit cur, nxt; int ui = 0;
    if (!S.next(0, cur)) return;
    f32x4 acc[2][2][4][2];
#pragma unroll
    for (int a = 0; a < 2; ++a)
#pragma unroll
        for (int b = 0; b < 2; ++b)
#pragma unroll
            for (int m = 0; m < 4; ++m)
#pragma unroll
                for (int n = 0; n < 2; ++n) acc[a][b][m][n] = (f32x4){0.f, 0.f, 0.f, 0.f};
    bf16x8 At[4][2], B0[2][2], B1[2][2];
    const char* cA = (const char*)g.A + (size_t)cur.pm * tstep; const char* cB = (const char*)g.Bt + (size_t)cur.pn * tstep;
    S.a_ready(cur);
    if constexpr (SP2) {
        PG8_STAGE(PG8_SB(0, 0), cB, voffB); PG8_STAGE(PG8_SB(0, 1), cB + hstep, voffB); PG8_STAGE(PG8_SA(0, 0), cA, voffA); PG8_STAGE(PG8_SA(0, 1), cA + hstep, voffA);
        if (wr == 1) PG8_BAR;
        PG8_WAIT_V(2); PG8_BAR;
        PG8_STAGE(PG8_SB(1, 0), cB + kstep, voffB); PG8_STAGE(PG8_SA(1, 0), cA + kstep, voffA); PG8_STAGE(PG8_SB(1, 1), cB + hstep + kstep, voffB);
        PG8_WAIT_V(6); PG8_BAR;
    } else {
        PG8_STAGE(PG8_SB(0, 0), cB, voffB); PG8_STAGE(PG8_SA(0, 0), cA, voffA); PG8_STAGE(PG8_SB(0, 1), cB + hstep, voffB); PG8_STAGE(PG8_SA(0, 1), cA + hstep, voffA);
        if (wr == 1) PG8_BAR;
        PG8_WAIT_V(4); PG8_BAR;
        PG8_STAGE(PG8_SB(1, 0), cB + kstep, voffB); PG8_STAGE(PG8_SA(1, 0), cA + kstep, voffA); PG8_STAGE(PG8_SB(1, 1), cB + hstep + kstep, voffB);
        PG8_WAIT_V(6); PG8_BAR;
    }
    for (;;) {
        const bool has_next = S.next(ui + 1, nxt);
        const char* nA = has_next ? (const char*)g.A + (size_t)nxt.pm * tstep : cA; const char* nB = has_next ? (const char*)g.Bt + (size_t)nxt.pn * tstep : cB;
        for (int t = 0; t < nt; t += 2) {
            const bool last = (t == nt - 2);
            const char* a1 = cA + (size_t)(t + 1) * kstep;
            const char* a2 = last ? nA : cA + (size_t)(t + 2) * kstep; const char* b2 = last ? nB : cB + (size_t)(t + 2) * kstep;
            const char* a3 = a2 + kstep; const char* b3 = b2 + kstep;
            if (last && has_next) S.a_ready(nxt);
            if constexpr (SP2) {
            PG8_LDB(B0, 0, 0); PG8_LDB(B1, 0, 1); PG8_SCHED; PG8_LDA(At, 0, 0); PG8_STAGE(PG8_SA(1, 1), a1 + hstep, voffA);
            PG8_WAIT_V(8); PG8_WAIT_L(0); PG8_BAR; PG8_MMA(0, 0, At, B0); PG8_MMA(0, 1, At, B1); PG8_BAR; PG8_SCHED;
            PG8_LDA(At, 0, 1); PG8_STAGE(PG8_SB(0, 0), b2, voffB); PG8_STAGE(PG8_SB(0, 1), b2 + hstep, voffB); PG8_STAGE(PG8_SA(0, 0), a2, voffA);
            PG8_WAIT_V(8); PG8_WAIT_L(0); PG8_BAR; PG8_MMA(1, 0, At, B0); PG8_MMA(1, 1, At, B1); PG8_BAR; PG8_SCHED;
            PG8_LDB(B0, 1, 0); PG8_LDB(B1, 1, 1); PG8_SCHED; PG8_LDA(At, 1, 0); PG8_STAGE(PG8_SA(0, 1), a2 + hstep, voffA);
            PG8_WAIT_V(8); PG8_WAIT_L(0); PG8_BAR; PG8_MMA(0, 0, At, B0); PG8_MMA(0, 1, At, B1); PG8_BAR; PG8_SCHED;
            PG8_LDA(At, 1, 1); PG8_STAGE(PG8_SB(1, 0), b3, voffB); PG8_STAGE(PG8_SB(1, 1), b3 + hstep, voffB); PG8_STAGE(PG8_SA(1, 0), a3, voffA);
            PG8_WAIT_V(8); PG8_WAIT_L(0); PG8_BAR; PG8_MMA(1, 0, At, B0); PG8_MMA(1, 1, At, B1); PG8_BAR; PG8_SCHED;
            } else {
            PG8_LDB(B0, 0, 0); PG8_SCHED; PG8_LDA(At, 0, 0); PG8_STAGE(PG8_SA(1, 1), a1 + hstep, voffA);
            PG8_WAIT_L(8); PG8_BAR; PG8_WAIT_L(0); PG8_MMA(0, 0, At, B0); PG8_BAR; PG8_SCHED;
            PG8_LDB(B1, 0, 1); PG8_STAGE(PG8_SB(0, 0), b2, voffB);
            PG8_BAR; PG8_WAIT_L(0); PG8_MMA(0, 1, At, B1); PG8_BAR;
            PG8_LDA(At, 0, 1); PG8_STAGE(PG8_SA(0, 0), a2, voffA);
            PG8_BAR; PG8_WAIT_L(0); PG8_MMA(1, 0, At, B0); PG8_BAR; PG8_SCHED;
            PG8_STAGE(PG8_SB(0, 1), b2 + hstep, voffB);
            PG8_WAIT_V(6); PG8_BAR; PG8_MMA(1, 1, At, B1); PG8_BAR;
            PG8_LDB(B0, 1, 0); PG8_SCHED; PG8_LDA(At, 1, 0); PG8_STAGE(PG8_SA(0, 1), a2 + hstep, voffA);
            PG8_WAIT_L(8); PG8_BAR; PG8_WAIT_L(0); PG8_MMA(0, 0, At, B0); PG8_BAR; PG8_SCHED;
            PG8_LDB(B1, 1, 1); PG8_STAGE(PG8_SB(1, 0), b3, voffB);
            PG8_BAR; PG8_WAIT_L(0); PG8_MMA(0, 1, At, B1); PG8_BAR;
            PG8_LDA(At, 1, 1); PG8_STAGE(PG8_SA(1, 0), a3, voffA);
            PG8_BAR; PG8_WAIT_L(0); PG8_MMA(1, 0, At, B0); PG8_BAR; PG8_SCHED;
            PG8_STAGE(PG8_SB(1, 1), b3 + hstep, voffB);
            PG8_WAIT_V(6); PG8_BAR; PG8_MMA(1, 1, At, B1); PG8_BAR;
            }
        }
        if constexpr (ALIGN_EPI) { if (wr == 0) PG8_BAR; }
        if constexpr (!Epi::AFTER_DRAIN) { E(acc, cur, wr, wc, fr, fq); S.done(cur); }
        if (!has_next) break;
#pragma unroll
        for (int a = 0; a < 2; ++a)
#pragma unroll
            for (int b = 0; b < 2; ++b)
#pragma unroll
                for (int m = 0; m < 4; ++m)
#pragma unroll
                    for (int n = 0; n < 2; ++n) acc[a][b][m][n] = (f32x4){0.f, 0.f, 0.f, 0.f};
        cur = nxt; cA = nA; cB = nB; ++ui;
        if constexpr (ALIGN_EPI) { if (wr == 1) PG8_BAR; }
    }
    PG8_WAIT_V(0);
    if constexpr (!ALIGN_EPI) { if (wr == 0) PG8_BAR; }
    PG8_BAR;
    if constexpr (Epi::AFTER_DRAIN) { E.fused(acc, cur, wr, wc, fr, fq, lds, wid, lane); S.done(cur); }
#undef PG8_SA
#undef PG8_SB
#undef PG8_STAGE
#undef PG8_LDA
#undef PG8_LDB
#undef PG8_MMA
#undef PG8_WAIT_V
#undef PG8_WAIT_L
#undef PG8_BAR
#undef PG8_SCHED
}
}
constexpr int BATCH = 8, SEQ = 4096, T = BATCH * SEQ, D = 1024, FF = 4096, AW = 2048, NGRP = 8, GDIM = 256, CHUNK = 128;
constexpr int NH = 16, NKV = 4, HD = 64, KVD = NKV * HD;
constexpr float EPS = 1e-6f;
constexpr float LOG2E = 1.4426950408889634f;
constexpr float QSCALE = 0.125f * LOG2E;

namespace pg8 {
typedef short s16x4 __attribute__((ext_vector_type(4)));
__device__ __forceinline__ void row_rstd(float (&rs)[2][4], const float* ssq, int row0, int fq, float mul) {
#pragma unroll
    for (int ai = 0; ai < 2; ++ai)
#pragma unroll
        for (int m = 0; m < 4; ++m) {
            const f32x4 p = *(const f32x4*)(ssq + (size_t)(row0 + ai * HALF + m * 16) * 16 + 4 * fq);
            float s = (p[0] + p[1]) + (p[2] + p[3]);
            s += __shfl_xor(s, 16); s += __shfl_xor(s, 32);
            rs[ai][m] = mul * (1.0f / sqrtf(s * (1.0f / 1024.0f) + 1e-6f));
        }
}
template <int ACT> struct EpiRowAct {
    static constexpr bool PERM = true, AFTER_DRAIN = false;
    bf16_t* O; int ldc; const float* ssq; float sc;
    __device__ __forceinline__ void operator()(const f32x4 (&acc)[2][2][4][2], const Unit& u, int wr, int wc, int fr, int fq) const {
        const int row0 = u.pm * BM + wr * 64 + fr, col0 = u.pn * BM + wc * 32 + 8 * fq;
        float rs[2][4]; row_rstd(rs, ssq, row0, fq, sc);
#pragma unroll
        for (int ai = 0; ai < 2; ++ai)
#pragma unroll
            for (int m = 0; m < 4; ++m) { bf16_t* rowp = O + (size_t)(row0 + ai * HALF + m * 16) * ldc + col0; const float r = rs[ai][m];
#pragma unroll
                for (int bj = 0; bj < 2; ++bj) { f32x4 v0 = acc[ai][bj][m][0] * r, v1 = acc[ai][bj][m][1] * r;
                    if (ACT == 1) { f32x2 a = gelu_pk((f32x2){v0[0], v0[1]}), b = gelu_pk((f32x2){v0[2], v0[3]}), c = gelu_pk((f32x2){v1[0], v1[1]}), d = gelu_pk((f32x2){v1[2], v1[3]});
                        v0 = (f32x4){a.x, a.y, b.x, b.y}; v1 = (f32x4){c.x, c.y, d.x, d.y}; }
                    if (ACT == 2) {
#pragma unroll
                        for (int e = 0; e < 4; ++e) { const float a = fmaxf(v0[e], 0.f), b = fmaxf(v1[e], 0.f); v0[e] = a * a; v1[e] = b * b; } }
                    u32x4 w; w.x = cvt_pk_bf16(v0[0], v0[1]); w.y = cvt_pk_bf16(v0[2], v0[3]); w.z = cvt_pk_bf16(v1[0], v1[1]); w.w = cvt_pk_bf16(v1[2], v1[3]);
                    *(u32x4*)(rowp + bj * HALF) = w; } }
    }
};
template <int ACT, bool STATS> struct EpiColAct {
    static constexpr bool PERM = true, AFTER_DRAIN = false;
    bf16_t* O; int ldc; const float* ssq; float* vsum; float* vsq;
    __device__ __forceinline__ void operator()(const f32x4 (&acc)[2][2][4][2], const Unit& u, int wr, int wc, int fr, int fq) const {
        const int row0 = u.pm * BM + wr * 64 + fr, col0 = u.pn * BM + wc * 32 + 8 * fq;
        float cs[2][8];
#pragma unroll
        for (int bj = 0; bj < 2; ++bj)
#pragma unroll
            for (int j = 0; j < 8; ++j) { float s = ssq[(size_t)(col0 + bj * HALF + j) * 16 + fr];
                s += __shfl_xor(s, 1); s += __shfl_xor(s, 2); s += __shfl_xor(s, 4); s += __shfl_xor(s, 8);
                cs[bj][j] = 1.0f / sqrtf(s * (1.0f / 1024.0f) + 1e-6f); }
        float psum[2][8], psq[2][8];
#pragma unroll
        for (int bj = 0; bj < 2; ++bj)
#pragma unroll
            for (int j = 0; j < 8; ++j) { psum[bj][j] = 0.f; psq[bj][j] = 0.f; }
#pragma unroll
        for (int ai = 0; ai < 2; ++ai)
#pragma unroll
            for (int m = 0; m < 4; ++m) { bf16_t* rowp = O + (size_t)(row0 + ai * HALF + m * 16) * ldc + col0;
#pragma unroll
                for (int bj = 0; bj < 2; ++bj) { f32x4 v0 = acc[ai][bj][m][0], v1 = acc[ai][bj][m][1];
#pragma unroll
                    for (int e = 0; e < 4; ++e) { v0[e] *= cs[bj][e]; v1[e] *= cs[bj][4 + e]; }
                    if (ACT == 1) { f32x2 a = gelu_pk((f32x2){v0[0], v0[1]}), b = gelu_pk((f32x2){v0[2], v0[3]}), c = gelu_pk((f32x2){v1[0], v1[1]}), d = gelu_pk((f32x2){v1[2], v1[3]});
                        v0 = (f32x4){a.x, a.y, b.x, b.y}; v1 = (f32x4){c.x, c.y, d.x, d.y}; }
                    if (STATS) {
#pragma unroll
                        for (int e = 0; e < 4; ++e) { psum[bj][e] += v0[e]; psq[bj][e] += v0[e] * v0[e]; psum[bj][4 + e] += v1[e]; psq[bj][4 + e] += v1[e] * v1[e]; } }
                    u32x4 w; w.x = cvt_pk_bf16(v0[0], v0[1]); w.y = cvt_pk_bf16(v0[2], v0[3]); w.z = cvt_pk_bf16(v1[0], v1[1]); w.w = cvt_pk_bf16(v1[2], v1[3]);
                    *(u32x4*)(rowp + bj * HALF) = w; } }
        if (STATS) {
#pragma unroll
            for (int bj = 0; bj < 2; ++bj)
#pragma unroll
                for (int j = 0; j < 8; ++j) { float s = psum[bj][j], q = psq[bj][j];
                    s += __shfl_xor(s, 1); s += __shfl_xor(s, 2); s += __shfl_xor(s, 4); s += __shfl_xor(s, 8);
                    q += __shfl_xor(q, 1); q += __shfl_xor(q, 2); q += __shfl_xor(q, 4); q += __shfl_xor(q, 8);
                    if (fr == 0) { const size_t si = (size_t)(col0 + bj * HALF + j) * 16 + u.pm * 2 + wr; vsum[si] = s; vsq[si] = q; } }
        }
    }
};
struct EpiResid {
    static constexpr bool PERM = true, AFTER_DRAIN = false;
    const float* base; float* out; bf16_t* hbf; float* ssq;
    __device__ __forceinline__ void operator()(const f32x4 (&acc)[2][2][4][2], const Unit& u, int wr, int wc, int fr, int fq) const {
        const int row0 = u.pm * BM + wr * 64 + fr, col0 = u.pn * BM + wc * 32 + 8 * fq;
#pragma unroll
        for (int ai = 0; ai < 2; ++ai)
#pragma unroll
            for (int m = 0; m < 4; ++m) { const int row = row0 + ai * HALF + m * 16; const size_t off = (size_t)row * 1024 + col0; float q = 0.f;
#pragma unroll
                for (int bj = 0; bj < 2; ++bj) {
                    const f32x4 b0 = *(const f32x4*)(base + off + bj * HALF), b1 = *(const f32x4*)(base + off + bj * HALF + 4);
                    const f32x4 v0 = acc[ai][bj][m][0] + b0, v1 = acc[ai][bj][m][1] + b1;
                    *(f32x4*)(out + off + bj * HALF) = v0; *(f32x4*)(out + off + bj * HALF + 4) = v1;
                    u32x4 w; w.x = cvt_pk_bf16(v0[0], v0[1]); w.y = cvt_pk_bf16(v0[2], v0[3]); w.z = cvt_pk_bf16(v1[0], v1[1]); w.w = cvt_pk_bf16(v1[2], v1[3]);
                    *(u32x4*)(hbf + off + bj * HALF) = w;
                    q += (v0[0] * v0[0] + v0[1] * v0[1]) + (v0[2] * v0[2] + v0[3] * v0[3]) + (v1[0] * v1[0] + v1[1] * v1[1]) + (v1[2] * v1[2] + v1[3] * v1[3]); }
                q += __shfl_xor(q, 16); q += __shfl_xor(q, 32);
                if (fq == 0) ssq[(size_t)row * 16 + u.pn * 4 + wc] = q; }
    }
};
}

constexpr size_t MiB = 1u << 20;
constexpr size_t WS_WIN = 0, WS_WOUT = 16 * MiB, WS_W1 = 24 * MiB, WS_W2 = 56 * MiB, WS_WQ = 88 * MiB, WS_WO = 92 * MiB, WS_WKV = 96 * MiB, WS_WC = 97 * MiB, WS_BIAS = 98 * MiB;
constexpr size_t WS_CTL = 99 * MiB, CTL_ZERO_BYTES = 16384;
constexpr size_t WS_SSQ = 100 * MiB, WS_VSUM = 102 * MiB, WS_VSQ = 104 * MiB, WS_HBF = 112 * MiB, WS_K = 176 * MiB, WS_VT = 192 * MiB, WS_R1 = 208 * MiB, WS_END = 464 * MiB;
constexpr int LDS_BYTES = 135168;
constexpr int NTHREADS = 512;

#define LAS __attribute__((address_space(3)))
typedef unsigned short bf16;
typedef unsigned u32x4 __attribute__((ext_vector_type(4)));
typedef unsigned u32x2 __attribute__((ext_vector_type(2)));
typedef float f32x4 __attribute__((ext_vector_type(4)));
typedef short bf16x8 __attribute__((ext_vector_type(8)));
typedef short s16x4 __attribute__((ext_vector_type(4)));

__device__ __forceinline__ unsigned pk2(float lo, float hi) { return pg8::cvt_pk_bf16(lo, hi); }
__device__ __forceinline__ float bf_lo(unsigned w) { return __uint_as_float(w << 16); }
__device__ __forceinline__ float bf_hi(unsigned w) { return __uint_as_float(w & 0xffff0000u); }
__device__ __forceinline__ float wave_sum(float v) {
#pragma unroll
    for (int o = 1; o < 64; o <<= 1) v += __shfl_xor(v, o);
    return v;
}

__device__ __forceinline__ void transpose_item(const float* W, int K, int N, const float* g, bf16* WT, LAS float* scr, int item, int lane) {
    const int nblk = N / 32, kb = item / nblk, nb = item % nblk, k0 = 64 * kb, n0 = 32 * nb;
#pragma unroll 8
    for (int i = 0; i < 32; ++i) { const int kk = 2 * i + (lane >> 5); float w = W[(size_t)(k0 + kk) * N + n0 + (lane & 31)]; if (g) w *= g[k0 + kk]; scr[kk * 33 + (lane & 31)] = w; }
    asm volatile("s_waitcnt lgkmcnt(0)" ::: "memory");
    const int c = lane & 7;
#pragma unroll
    for (int j = 0; j < 4; ++j) { const int n = (lane >> 3) + 8 * j; const LAS float* s = scr + (8 * c) * 33 + n;
        u32x4 o; o.x = pk2(s[0 * 33], s[1 * 33]); o.y = pk2(s[2 * 33], s[3 * 33]); o.z = pk2(s[4 * 33], s[5 * 33]); o.w = pk2(s[6 * 33], s[7 * 33]);
        *(u32x4*)(WT + (size_t)(n0 + n) * K + k0 + 8 * c) = o; }
    asm volatile("s_waitcnt lgkmcnt(0)" ::: "memory");
}

struct Args {
    const float* x; const float* mix_g; const float* ffn_g; const float* a_w_in; const float* a_ln_g; const float* a_w_s; const float* a_b_s; const float* a_w_out;
    const float* kv_g; const float* w_k; const float* w_v; const float* b_w_q; const float* b_sinks; const float* b_w_o; const float* rel_bias; const float* ffn_w1; const float* ffn_w2; const float* final_g;
    float* out; unsigned char* ws;
};

__device__ __forceinline__ void prologue(const Args& a, LAS unsigned char* lds) {
    const int tid = opaque_tid(), lane = tid & 63, wave = tid >> 6;
    LAS float* scr = (LAS float*)(lds + wave * 16384);
    const int gw = blockIdx.x * 8 + wave, NGW = gridDim.x * 8;
    unsigned char* ws = a.ws;
    constexpr int I_IN = (D / 64) * (4096 / 32), I_OUT = (AW / 64) * (D / 32), I_1 = (D / 64) * (FF / 32), I_2 = (FF / 64) * (D / 32), I_Q = (D / 64) * (D / 32), I_KV = (D / 64) * (KVD / 32);
    constexpr int NITEMS = 2 * I_IN + 2 * I_OUT + 4 * I_1 + 4 * I_2 + 2 * I_Q + 2 * I_Q + 2 * I_KV;
    for (int it = gw; it < NITEMS; it += NGW) {
        int r = it;
#define TR(CNT, W, Kd, Nd, G, DST) if (r < (CNT)) { transpose_item((W), (Kd), (Nd), (G), (bf16*)(DST), scr, r, lane); continue; } r -= (CNT);
        TR(I_IN, a.a_w_in, D, 4096, a.mix_g, ws + WS_WIN)
        TR(I_IN, a.a_w_in + (size_t)D * 4096, D, 4096, a.mix_g + D, ws + WS_WIN + (size_t)D * 4096 * 2)
        TR(I_OUT, a.a_w_out, AW, D, nullptr, ws + WS_WOUT)
        TR(I_OUT, a.a_w_out + (size_t)AW * D, AW, D, nullptr, ws + WS_WOUT + (size_t)AW * D * 2)
        TR(I_1, a.ffn_w1 + 0 * (size_t)D * FF, D, FF, a.ffn_g + 0 * D, ws + WS_W1 + 0 * (size_t)D * FF * 2)
        TR(I_1, a.ffn_w1 + 1 * (size_t)D * FF, D, FF, a.ffn_g + 1 * D, ws + WS_W1 + 1 * (size_t)D * FF * 2)
        TR(I_1, a.ffn_w1 + 2 * (size_t)D * FF, D, FF, a.ffn_g + 2 * D, ws + WS_W1 + 2 * (size_t)D * FF * 2)
        TR(I_1, a.ffn_w1 + 3 * (size_t)D * FF, D, FF, a.ffn_g + 3 * D, ws + WS_W1 + 3 * (size_t)D * FF * 2)
        TR(I_2, a.ffn_w2 + 0 * (size_t)D * FF, FF, D, nullptr, ws + WS_W2 + 0 * (size_t)D * FF * 2)
        TR(I_2, a.ffn_w2 + 1 * (size_t)D * FF, FF, D, nullptr, ws + WS_W2 + 1 * (size_t)D * FF * 2)
        TR(I_2, a.ffn_w2 + 2 * (size_t)D * FF, FF, D, nullptr, ws + WS_W2 + 2 * (size_t)D * FF * 2)
        TR(I_2, a.ffn_w2 + 3 * (size_t)D * FF, FF, D, nullptr, ws + WS_W2 + 3 * (size_t)D * FF * 2)
        TR(I_Q, a.b_w_q, D, D, a.mix_g + 2 * D, ws + WS_WQ)
        TR(I_Q, a.b_w_q + (size_t)D * D, D, D, a.mix_g + 3 * D, ws + WS_WQ + (size_t)D * D * 2)
        TR(I_Q, a.b_w_o, D, D, nullptr, ws + WS_WO)
        TR(I_Q, a.b_w_o + (size_t)D * D, D, D, nullptr, ws + WS_WO + (size_t)D * D * 2)
        TR(I_KV, a.w_k, D, KVD, a.kv_g, ws + WS_WKV)
        TR(I_KV, a.w_v, D, KVD, a.kv_g, ws + WS_WKV + (size_t)D * KVD * 2)
#undef TR
    }
    {
        bf16* wc = (bf16*)(ws + WS_WC);
        const int gt = blockIdx.x * NTHREADS + tid, NT = gridDim.x * NTHREADS;
        for (int i = gt; i < 2 * NGRP * CHUNK * CHUNK / 2; i += NT) {
            const int e = 2 * i, col = e & 127, row = (e >> 7) & 127;
            const float w0 = (col <= row) ? a.a_w_s[e] : 0.f, w1 = (col + 1 <= row) ? a.a_w_s[e + 1] : 0.f;
            ((unsigned*)wc)[i] = pk2(w0, w1);
        }
        float* b2 = (float*)(ws + WS_BIAS);
        for (int i = gt; i < NH * 128; i += NT) {
            const int h = i >> 7, d = i & 127; int bucket;
            if (d < 16) bucket = d;
            else { const float lr = logf((float)d / 16.0f) / logf(8.0f); int l = 16 + (int)(lr * 16.0f); bucket = l < 31 ? l : 31; }
            b2[i] = a.rel_bias[bucket * NH + h] * LOG2E;
        }
    }
    {
        bf16* hbf = (bf16*)(ws + WS_HBF); float* ssq = (float*)(ws + WS_SSQ);
        for (int m = gw; m < T; m += NGW) {
            const f32x4* xr = (const f32x4*)(a.x + (size_t)m * D) + lane; f32x4 v[4]; float s = 0.f;
#pragma unroll
            for (int j = 0; j < 4; ++j) { v[j] = xr[64 * j]; s += (v[j][0] * v[j][0] + v[j][1] * v[j][1]) + (v[j][2] * v[j][2] + v[j][3] * v[j][3]); }
            s = wave_sum(s);
            u32x2* o8 = (u32x2*)(hbf + (size_t)m * D) + lane;
#pragma unroll
            for (int j = 0; j < 4; ++j) { u32x2 w; w.x = pk2(v[j][0], v[j][1]); w.y = pk2(v[j][2], v[j][3]); o8[64 * j] = w; }
            if (lane < 16) ssq[(size_t)m * 16 + lane] = (lane == 0) ? s : 0.f;
        }
    }
}

__device__ __forceinline__ void sgu_phase(LAS unsigned char* lds, const bf16* WcBf, const float* lng, const float* bs, const bf16* vT, bf16* u, const float* vsum, const float* vsq, bf16* dst, size_t dmask) {
    const int tid = opaque_tid(), wid = tid >> 6, lane = tid & 63, fr = lane & 15, fq = lane >> 4, wr = wid >> 2, wc = wid & 3;
    LAS unsigned char* As = lds;
    LAS unsigned char* Bs = lds + 34816;
    LAS float* MU = (LAS float*)(lds + 34816 + 69632); LAS float* RS = MU + 128;
    for (int unit = blockIdx.x; unit < (T / CHUNK) * NGRP; unit += gridDim.x) {
        const int n = unit >> 3, g = unit & 7, tok0 = n * CHUNK;
        if (tid < 128) {
            const f32x4* ps = (const f32x4*)(vsum + (size_t)(tok0 + tid) * 16); const f32x4* pq = (const f32x4*)(vsq + (size_t)(tok0 + tid) * 16); float s = 0.f, q = 0.f;
#pragma unroll
            for (int i = 0; i < 4; ++i) { const f32x4 a = ps[i], b = pq[i]; s += (a[0] + a[1]) + (a[2] + a[3]); q += (b[0] + b[1]) + (b[2] + b[3]); }
            const float mean = s * (1.0f / 2048.0f); float var = q * (1.0f / 2048.0f) - mean * mean; var = var > 0.f ? var : 0.f;
            MU[tid] = mean; RS[tid] = 1.0f / sqrtf(var + EPS);
        }
        const bf16* Ag = WcBf + (size_t)g * CHUNK * CHUNK;
#pragma unroll
        for (int i = 0; i < 4; ++i) { const int q = tid + 512 * i, r = q >> 4, c8 = (q & 15) * 8; const u32x4 v = *(const u32x4*)(Ag + r * 128 + c8); *(LAS u32x4*)(As + r * 272 + c8 * 2) = v; }
        __syncthreads();
        {
            const int jc = (tid & 15) * 8; float mu[8], rs[8];
#pragma unroll
            for (int j = 0; j < 8; ++j) { mu[j] = MU[jc + j]; rs[j] = RS[jc + j]; }
#pragma unroll
            for (int i = 0; i < 8; ++i) { const int q = tid + 512 * i, r = q >> 4, chan = g * GDIM + r;
                const u32x4 raw = *(const u32x4*)(vT + (size_t)chan * T + tok0 + jc); const float gc = lng[chan];
                float y[8]; y[0] = bf_lo(raw.x); y[1] = bf_hi(raw.x); y[2] = bf_lo(raw.y); y[3] = bf_hi(raw.y); y[4] = bf_lo(raw.z); y[5] = bf_hi(raw.z); y[6] = bf_lo(raw.w); y[7] = bf_hi(raw.w);
#pragma unroll
                for (int j = 0; j < 8; ++j) y[j] = (y[j] - mu[j]) * rs[j] * gc;
                u32x4 w; w.x = pk2(y[0], y[1]); w.y = pk2(y[2], y[3]); w.z = pk2(y[4], y[5]); w.w = pk2(y[6], y[7]);
                const int pos = (r & ~31) + 16 * ((r >> 2) & 1) + 4 * ((r >> 3) & 3) + (r & 3);
                *(LAS u32x4*)(Bs + pos * 272 + jc * 2) = w; }
        }
        __syncthreads();
        f32x4 acc[4][4];
#pragma unroll
        for (int m = 0; m < 4; ++m)
#pragma unroll
            for (int nn = 0; nn < 4; ++nn) acc[m][nn] = (f32x4){0.f, 0.f, 0.f, 0.f};
        const int nk = wr ? 4 : 2;
        for (int kk = 0; kk < nk; ++kk) {
            bf16x8 af[4], bfr[4];
#pragma unroll
            for (int m = 0; m < 4; ++m) af[m] = *(const LAS bf16x8*)(As + (64 * wr + 16 * m + fr) * 272 + kk * 64 + fq * 16);
#pragma unroll
            for (int nn = 0; nn < 4; ++nn) bfr[nn] = *(const LAS bf16x8*)(Bs + (64 * wc + 16 * nn + fr) * 272 + kk * 64 + fq * 16);
#pragma unroll
            for (int m = 0; m < 4; ++m)
#pragma unroll
                for (int nn = 0; nn < 4; ++nn) acc[m][nn] = __builtin_amdgcn_mfma_f32_16x16x32_bf16(bfr[nn], af[m], acc[m][nn], 0, 0, 0);
        }
#pragma unroll
        for (int m = 0; m < 4; ++m) { const int i = 64 * wr + 16 * m + fr; const float bi = bs[g * CHUNK + i];
#pragma unroll
            for (int p = 0; p < 2; ++p) { bf16* up = u + (size_t)(tok0 + i) * AW + g * GDIM + 64 * wc + 32 * p + 8 * fq;
                const u32x4 uv = *(const u32x4*)up; const f32x4 a0 = acc[m][2 * p], a1 = acc[m][2 * p + 1];
                u32x4 w;
                w.x = pk2(bf_lo(uv.x) * (a0[0] + bi), bf_hi(uv.x) * (a0[1] + bi)); w.y = pk2(bf_lo(uv.y) * (a0[2] + bi), bf_hi(uv.y) * (a0[3] + bi));
                w.z = pk2(bf_lo(uv.z) * (a1[0] + bi), bf_hi(uv.z) * (a1[1] + bi)); w.w = pk2(bf_lo(uv.w) * (a1[2] + bi), bf_hi(uv.w) * (a1[3] + bi));
                *(u32x4*)(dst + (((size_t)(tok0 + i) * AW + g * GDIM + 64 * wc + 32 * p + 8 * fq) & dmask)) = w; } }
        __syncthreads();
    }
}

__device__ __forceinline__ void attn_phase(LAS unsigned char* lds, const bf16* Q, const bf16* Kb, const bf16* VT, bf16* O, const float* bias2, const float* sinks) {
    const int tid = opaque_tid(), wid = tid >> 6, lane = tid & 63, fr = lane & 15, fq = lane >> 4;
    LAS unsigned char* Ks = lds;
    LAS unsigned char* Vs = lds + 36864;
    LAS float* Bt = (LAS float*)(lds + 36864 + 33792);
    for (int unit = blockIdx.x; unit < BATCH * (SEQ / 128) * NKV; unit += gridDim.x) {
        const int kh = unit & 3, nb = (unit >> 2) & 31, b = unit >> 7, tok0 = b * SEQ + nb * 128, kt0 = tok0 - 128;
#pragma unroll
        for (int i = 0; i < 4; ++i) { const int q = tid + 512 * i, r = q >> 3, c8 = (q & 7) * 8; u32x4 v = (u32x4){0u, 0u, 0u, 0u};
            if (nb > 0 || r >= 128) v = *(const u32x4*)(Kb + (size_t)(kt0 + r) * KVD + kh * HD + c8);
            *(LAS u32x4*)(Ks + r * 144 + c8 * 2) = v; }
#pragma unroll
        for (int i = 0; i < 4; ++i) { const int q = tid + 512 * i, r = q >> 5, c8 = (q & 31) * 8; u32x4 v = (u32x4){0u, 0u, 0u, 0u};
            if (nb > 0 || c8 >= 128) v = *(const u32x4*)(VT + (size_t)(kh * HD + r) * T + kt0 + c8);
            *(LAS u32x4*)(Vs + r * 528 + c8 * 2) = v; }
        Bt[tid] = bias2[(kh * 4 + (tid >> 7)) * 128 + (tid & 127)];
        __syncthreads();
        const int hq = kh * 4 + (wid >> 1); const float sink2 = sinks[hq] * LOG2E;
        const LAS float* bt = Bt + (wid >> 1) * 128;
        for (int grp = 0; grp < 4; ++grp) {
            const int q0 = 64 * (wid & 1) + 16 * grp, tl = q0 >> 4;
            bf16x8 yq[2];
#pragma unroll
            for (int kk = 0; kk < 2; ++kk) yq[kk] = *(const bf16x8*)(Q + (size_t)(tok0 + q0 + fr) * D + hq * HD + kk * 32 + fq * 8);
            f32x4 S[9];
#pragma unroll
            for (int t = 0; t < 9; ++t) { S[t] = (f32x4){0.f, 0.f, 0.f, 0.f};
#pragma unroll
                for (int kk = 0; kk < 2; ++kk) { const bf16x8 xk = *(const LAS bf16x8*)(Ks + (16 * (tl + t) + fr) * 144 + kk * 64 + fq * 16);
                    S[t] = __builtin_amdgcn_mfma_f32_16x16x32_bf16(xk, yq[kk], S[t], 0, 0, 0); } }
            float mx = sink2;
#pragma unroll
            for (int t = 0; t < 9; ++t)
#pragma unroll
                for (int e = 0; e < 4; ++e) { const int dist = fr + 128 - 16 * t - 4 * fq - e, kj = 16 * (tl + t) + 4 * fq + e;
                    const bool valid = (dist >= 0) && (dist < 128) && (nb > 0 || kj >= 128);
                    const float l2 = valid ? S[t][e] + bt[dist & 127] : -1e30f; S[t][e] = l2; mx = fmaxf(mx, l2); }
            mx = fmaxf(mx, __shfl_xor(mx, 16)); mx = fmaxf(mx, __shfl_xor(mx, 32));
            float l = 0.f;
#pragma unroll
            for (int t = 0; t < 9; ++t)
#pragma unroll
                for (int e = 0; e < 4; ++e) { const float p = __builtin_amdgcn_exp2f(S[t][e] - mx); S[t][e] = p; l += p; }
            l += __shfl_xor(l, 16); l += __shfl_xor(l, 32); l += __builtin_amdgcn_exp2f(sink2 - mx);
            bf16x8 yp[5];
#pragma unroll
            for (int pp = 0; pp < 5; ++pp) { const f32x4 lo = S[2 * pp]; const f32x4 hi = (2 * pp + 1 < 9) ? S[(2 * pp + 1 < 9) ? 2 * pp + 1 : 8] : (f32x4){0.f, 0.f, 0.f, 0.f};
                u32x4 w; w.x = pk2(lo[0], lo[1]); w.y = pk2(lo[2], lo[3]); w.z = pk2(hi[0], hi[1]); w.w = pk2(hi[2], hi[3]); yp[pp] = __builtin_bit_cast(bf16x8, w); }
            f32x4 Oa[4];
#pragma unroll
            for (int dt = 0; dt < 4; ++dt) { Oa[dt] = (f32x4){0.f, 0.f, 0.f, 0.f};
#pragma unroll
                for (int pp = 0; pp < 5; ++pp) { const int ta = tl + 2 * pp, tb = (2 * pp + 1 < 9) ? ta + 1 : ta;
                    const s16x4 va = *(const LAS s16x4*)(Vs + (16 * dt + fr) * 528 + (16 * ta + 4 * fq) * 2), vb = *(const LAS s16x4*)(Vs + (16 * dt + fr) * 528 + (16 * tb + 4 * fq) * 2);
                    const bf16x8 xv = (bf16x8){va[0], va[1], va[2], va[3], vb[0], vb[1], vb[2], vb[3]};
                    Oa[dt] = __builtin_amdgcn_mfma_f32_16x16x32_bf16(xv, yp[pp], Oa[dt], 0, 0, 0); } }
            const float inv = 1.0f / l;
            bf16* op = O + (size_t)(tok0 + q0 + fr) * D + hq * HD + 4 * fq;
#pragma unroll
            for (int dt = 0; dt < 4; ++dt) { u32x2 w; w.x = pk2(Oa[dt][0] * inv, Oa[dt][1] * inv); w.y = pk2(Oa[dt][2] * inv, Oa[dt][3] * inv); *(u32x2*)(op + 16 * dt) = w; }
        }
        __syncthreads();
    }
}

__device__ __forceinline__ void final_norm(float* out, const float* ssq, const float* g) {
    const int tid = opaque_tid(), lane = tid & 63, wave = tid >> 6;
    const int gw = blockIdx.x * 8 + wave, NGW = gridDim.x * 8;
    f32x4 gv[4];
#pragma unroll
    for (int j = 0; j < 4; ++j) gv[j] = ((const f32x4*)g)[lane + 64 * j];
    for (int m = gw; m < T; m += NGW) {
        float s = ssq[(size_t)m * 16 + (lane & 15)];
        s += __shfl_xor(s, 1); s += __shfl_xor(s, 2); s += __shfl_xor(s, 4); s += __shfl_xor(s, 8);
        const float r = 1.0f / sqrtf(s * (1.0f / 1024.0f) + EPS);
        f32x4* xr = (f32x4*)(out + (size_t)m * D) + lane;
#pragma unroll
        for (int j = 0; j < 4; ++j) { f32x4 v = xr[64 * j]; v = v * r * gv[j]; xr[64 * j] = v; }
    }
}

#define XB_TMO      128
#define XB_XCNT(j)  (256  + 64 * (j))
#define XB_XSUB(j)  (1280 + 64 * (j))
#define XB_XGEN(j)  (2304 + 64 * (j))
#define XB_TOP      3328
#define XB_TOPGEN   3392
#define XCD_BAR_WORDS 3456
#define XB_SPIN_CAP (1u << 18)

__device__ __forceinline__ unsigned xb_ld(unsigned* p)              { return __hip_atomic_load(p, __ATOMIC_RELAXED, __HIP_MEMORY_SCOPE_AGENT); }
__device__ __forceinline__ unsigned xb_add(unsigned* p, unsigned v) { return __hip_atomic_fetch_add(p, v, __ATOMIC_RELAXED, __HIP_MEMORY_SCOPE_AGENT); }
__device__ __forceinline__ unsigned xb_xcc_id() { return (unsigned)__builtin_amdgcn_s_getreg((3 << 11) | 20) & 0xFu; }
#define XB_SPIN(cond, bar) do { unsigned _sp = 0; while (cond) { __builtin_amdgcn_s_sleep(1); \
    if ((++_sp & 255u) == 0u) { if (xb_ld(&(bar)[XB_TMO])) break; if (_sp > XB_SPIN_CAP) { atomicAdd(&(bar)[XB_TMO], 1u); break; } } } } while (0)

struct XcdBarrier {
    unsigned* bar; unsigned x;
    volatile LAS unsigned* st;
};

__device__ __forceinline__ XcdBarrier xcd_barrier_post(unsigned* bar, volatile LAS unsigned* st) {
    XcdBarrier b; b.bar = bar; b.x = xb_xcc_id(); b.st = st;
    if (threadIdx.x == 0) (void)xb_add(&bar[XB_XCNT(b.x)], 1u);
    return b;
}
__device__ __forceinline__ void xcd_barrier_complete(unsigned* bar, unsigned x, unsigned& nloc, unsigned& nx) {
    const unsigned G = gridDim.x * gridDim.y * gridDim.z;
    unsigned sum, cnt, mine, sp = 0u;
    for (;;) {
        sum = 0u; cnt = 0u; mine = 0u;
#pragma unroll
        for (unsigned j = 0; j < 16; ++j) { const unsigned c = xb_ld(&bar[XB_XCNT(j)]); sum += c; cnt += (c > 0u) ? 1u : 0u; mine = (j == x) ? c : mine; }
        if (sum == G) break;
        __builtin_amdgcn_s_sleep(1);
        if ((++sp & 255u) == 0u) { if (xb_ld(&bar[XB_TMO])) break; if (sp > XB_SPIN_CAP) { atomicAdd(&bar[XB_TMO], 1u); break; } }
    }
    nloc = mine > 0u ? mine : 1u; nx = cnt > 0u ? cnt : 1u;
}

__device__ __forceinline__ void xcd_barrier(const XcdBarrier& b) {
    asm volatile("s_waitcnt vmcnt(0)" ::: "memory");
    __syncthreads();
    if (threadIdx.x == 0) {
        unsigned* bar = b.bar;
        __builtin_amdgcn_s_waitcnt(0);
        unsigned nloc = b.st[0], nx = b.st[1];
        if (nloc == 0u) { xcd_barrier_complete(bar, b.x, nloc, nx); b.st[0] = nloc; b.st[1] = nx; }
        const unsigned old = xb_add(&bar[XB_XSUB(b.x)], 1u);
        const unsigned gen = old / nloc;
        if (old + 1u == (gen + 1u) * nloc) {
            __builtin_amdgcn_fence(__ATOMIC_RELEASE, "agent");
            asm volatile("s_waitcnt vmcnt(0)" ::: "memory");
            const unsigned og = xb_add(&bar[XB_TOP], 1u);
            const unsigned tg = og / nx;
            if (og + 1u == (tg + 1u) * nx) xb_add(&bar[XB_TOPGEN], 1u);
            else XB_SPIN(xb_ld(&bar[XB_TOPGEN]) == tg, bar);
            __builtin_amdgcn_fence(__ATOMIC_ACQUIRE, "agent");
            xb_add(&bar[XB_XGEN(b.x)], 1u);
            asm volatile("s_waitcnt vmcnt(0)" ::: "memory");
        } else {
            XB_SPIN(xb_ld(&bar[XB_XGEN(b.x)]) == gen, bar);
            __builtin_amdgcn_fence(__ATOMIC_ACQUIRE, "agent");
            asm volatile("s_waitcnt vmcnt(0)" ::: "memory");
        }
    }
    __syncthreads();
}

#ifndef PROBE_SYNC2
#define PROBE_SYNC2 0
#endif
#ifndef PROBE_ATT2
#define PROBE_ATT2 0
#endif
#ifndef PROBE_SGU2
#define PROBE_SGU2 0
#endif
#ifndef PROBE_PRO2
#define PROBE_PRO2 0
#endif
#ifndef PROBE_FFN2X
#define PROBE_FFN2X 0
#endif
#define GSYNC() do { xcd_barrier(bar); if (PROBE_SYNC2) xcd_barrier(bar); } while (0)
#ifndef PHASE_MASK
#define PHASE_MASK 0xFFFF
#endif
#define PH(b) if constexpr ((PHASE_MASK >> (b)) & 1)
__global__ void __launch_bounds__(NTHREADS, 2) fwd_megakernel(Args a) {
    extern __shared__ __attribute__((aligned(16))) unsigned char lds_raw[];
    LAS unsigned char* lds = (LAS unsigned char*)lds_raw;
    cg::grid_group grid = cg::this_grid();
    unsigned char* ws = a.ws;
    const int G = gridDim.x, c = blockIdx.x;
    bf16* hbf = (bf16*)(ws + WS_HBF); float* ssq = (float*)(ws + WS_SSQ); float* vsum = (float*)(ws + WS_VSUM); float* vsq = (float*)(ws + WS_VSQ);
    bf16* R1 = (bf16*)(ws + WS_R1);

    volatile LAS unsigned* MISC = (volatile LAS unsigned*)(lds + 131072);
    if (threadIdx.x < 16) MISC[threadIdx.x] = 0u;
    __syncthreads();
    XcdBarrier bar = xcd_barrier_post((unsigned*)(ws + WS_CTL), MISC + 8);
    PH(0) prologue(a, lds);
    if (PROBE_PRO2) prologue(a, lds);
    grid.sync();

    for (int layer = 0; layer < 4; ++layer) {
        const bf16* mixA; const bf16* mixW; int mixK;
        if (layer < 2) {
            const bf16* Win = (const bf16*)(ws + WS_WIN) + (size_t)layer * 4096 * D;
            bf16* U = R1; bf16* VTt = R1 + (size_t)T * AW;
            PH(1) {
                pg8::Gemm g{hbf, Win, T, AW, D}; pg8::StaticOrder S; S.init(T, AW, G, c);
                pg8::EpiRowAct<1> E{U, AW, ssq, 1.0f};
                pg8::gemm_phase<pg8::EpiRowAct<1>, pg8::StaticOrder, true, true>(lds, g, S, E);
            }
            PH(2) {
                pg8::Gemm g{Win + (size_t)AW * D, hbf, AW, T, D}; pg8::StaticOrder S; S.init(AW, T, G, c);
                pg8::EpiColAct<1, true> E{VTt, T, ssq, vsum, vsq};
                pg8::gemm_phase<pg8::EpiColAct<1, true>, pg8::StaticOrder, true, true>(lds, g, S, E);
            }
            GSYNC();
            if (PROBE_SGU2) sgu_phase(lds, (const bf16*)(ws + WS_WC) + (size_t)layer * NGRP * CHUNK * CHUNK, a.a_ln_g + (size_t)layer * AW, a.a_b_s + (size_t)layer * NGRP * CHUNK, VTt, U, vsum, vsq, hbf, ((size_t)32 << 20) - 1);
            PH(3) sgu_phase(lds, (const bf16*)(ws + WS_WC) + (size_t)layer * NGRP * CHUNK * CHUNK, a.a_ln_g + (size_t)layer * AW, a.a_b_s + (size_t)layer * NGRP * CHUNK, VTt, U, vsum, vsq, U, ~(size_t)0);
            GSYNC();
            mixA = U; mixW = (const bf16*)(ws + WS_WOUT) + (size_t)layer * D * AW; mixK = AW;
        } else {
            const int j = layer - 2;
            bf16* Qb = R1; bf16* Ob = R1 + (size_t)T * D; bf16* Kb = (bf16*)(ws + WS_K); bf16* VTb = (bf16*)(ws + WS_VT);
            PH(4) {
                pg8::Gemm g{hbf, (const bf16*)(ws + WS_WQ) + (size_t)j * D * D, T, D, D}; pg8::StaticOrder S; S.init(T, D, G, c);
                pg8::EpiRowAct<0> E{Qb, D, ssq, QSCALE};
                pg8::gemm_phase<pg8::EpiRowAct<0>, pg8::StaticOrder, true, true>(lds, g, S, E);
            }
            if (layer == 2) {
                PH(5) {
                    pg8::Gemm g{hbf, (const bf16*)(ws + WS_WKV), T, KVD, D}; pg8::StaticOrder S; S.init(T, KVD, G, c);
                    pg8::EpiRowAct<0> E{Kb, KVD, ssq, 1.0f};
                    pg8::gemm_phase<pg8::EpiRowAct<0>, pg8::StaticOrder, true, true>(lds, g, S, E);
                }
                PH(6) {
                    pg8::Gemm g{(const bf16*)(ws + WS_WKV) + (size_t)D * KVD, hbf, KVD, T, D}; pg8::StaticOrder S; S.init(KVD, T, G, (c + G / 2) % G);
                    pg8::EpiColAct<0, false> E{VTb, T, ssq, nullptr, nullptr};
                    pg8::gemm_phase<pg8::EpiColAct<0, false>, pg8::StaticOrder, true, true>(lds, g, S, E);
                }
            }
            GSYNC();
            if (PROBE_ATT2) attn_phase(lds, Qb, Kb, VTb, Ob, (const float*)(ws + WS_BIAS), a.b_sinks + j * NH);
            PH(7) attn_phase(lds, Qb, Kb, VTb, Ob, (const float*)(ws + WS_BIAS), a.b_sinks + j * NH);
            GSYNC();
            mixA = Ob; mixW = (const bf16*)(ws + WS_WO) + (size_t)j * D * D; mixK = D;
        }
        PH(8) {
            pg8::Gemm g{mixA, mixW, T, D, mixK}; pg8::StaticOrder S; S.init(T, D, G, c);
            pg8::EpiResid E{layer == 0 ? a.x : a.out, a.out, hbf, ssq};
            pg8::gemm_phase<pg8::EpiResid, pg8::StaticOrder, true, true>(lds, g, S, E);
        }
        GSYNC();
        bf16* Fb = R1;
        PH(9) {
            pg8::Gemm g{hbf, (const bf16*)(ws + WS_W1) + (size_t)layer * D * FF, T, FF, D}; pg8::StaticOrder S; S.init(T, FF, G, c);
            pg8::EpiRowAct<2> E{Fb, FF, ssq, 1.0f};
            pg8::gemm_phase<pg8::EpiRowAct<2>, pg8::StaticOrder, true, true>(lds, g, S, E);
        }
        GSYNC();
        PH(10) {
            pg8::Gemm g{Fb, (const bf16*)(ws + WS_W2) + (size_t)layer * D * FF, T, D, FF}; pg8::StaticOrder S; S.init(T, D, G, c);
            pg8::EpiResid E{a.out, a.out, hbf, ssq};
            pg8::gemm_phase<pg8::EpiResid, pg8::StaticOrder, true, true>(lds, g, S, E);
        }
        GSYNC();
    }
    PH(11) final_norm(a.out, ssq, a.final_g);
}

extern "C" void kernel_launch(void* const* d_in, const int* in_sizes, int n_in, void* d_out, int out_size, void* d_ws, size_t ws_size, hipStream_t stream) {
    static int grid = 0;
    if (grid == 0) {
        if (n_in != 18 || in_sizes[0] != T * D || out_size != T * D || ws_size < WS_END) { fprintf(stderr, "kernel_launch: unexpected shapes (n_in %d in0 %d out %d ws %zu)\n", n_in, n_in > 0 ? in_sizes[0] : -1, out_size, ws_size); grid = -1; return; }
        int dev = 0, cus = 0, per_cu = 0;
        hipGetDevice(&dev); hipDeviceGetAttribute(&cus, hipDeviceAttributeMultiprocessorCount, dev);
        if (hipFuncSetAttribute((const void*)fwd_megakernel, hipFuncAttributeMaxDynamicSharedMemorySize, LDS_BYTES) != hipSuccess) { fprintf(stderr, "kernel_launch: hipFuncSetAttribute failed\n"); grid = -1; return; }
        if (hipOccupancyMaxActiveBlocksPerMultiprocessor(&per_cu, (const void*)fwd_megakernel, NTHREADS, LDS_BYTES) != hipSuccess || per_cu < 1) { fprintf(stderr, "kernel_launch: occupancy query says %d\n", per_cu); per_cu = 1; }
        (void)hipGetLastError();
        grid = cus * 1;
    }
    if (grid < 0) return;
    if (hipMemsetAsync((char*)d_ws + WS_CTL, 0, CTL_ZERO_BYTES, stream) != hipSuccess) { fprintf(stderr, "kernel_launch: memset failed\n"); return; }
    Args a{};
    a.x = (const float*)d_in[0]; a.mix_g = (const float*)d_in[1]; a.ffn_g = (const float*)d_in[2]; a.a_w_in = (const float*)d_in[3]; a.a_ln_g = (const float*)d_in[4];
    a.a_w_s = (const float*)d_in[5]; a.a_b_s = (const float*)d_in[6]; a.a_w_out = (const float*)d_in[7]; a.kv_g = (const float*)d_in[8]; a.w_k = (const float*)d_in[9];
    a.w_v = (const float*)d_in[10]; a.b_w_q = (const float*)d_in[11]; a.b_sinks = (const float*)d_in[12]; a.b_w_o = (const float*)d_in[13]; a.rel_bias = (const float*)d_in[14];
    a.ffn_w1 = (const float*)d_in[15]; a.ffn_w2 = (const float*)d_in[16]; a.final_g = (const float*)d_in[17];
    a.out = (float*)d_out; a.ws = (unsigned char*)d_ws;
    void* args[] = {&a};
    hipError_t e = hipLaunchCooperativeKernel((const void*)fwd_megakernel, dim3(grid), dim3(NTHREADS), args, LDS_BYTES, stream);
    if (e != hipSuccess) fprintf(stderr, "kernel_launch: cooperative launch failed: %s (grid %d)\n", hipGetErrorString(e), grid);
}
```

```cpp
#include <hip/hip_runtime.h>
#include <hip/hip_cooperative_groups.h>
#include <cstdio>
#include <cstdint>
namespace cg = cooperative_groups;
__device__ __forceinline__ int opaque_tid() { int t = threadIdx.x; asm volatile("" : "+v"(t)); return t; }

namespace pg8 {
#define PG8_LAS __attribute__((address_space(3)))
typedef unsigned short bf16_t;
typedef short bf16x8 __attribute__((ext_vector_type(8)));
typedef float f32x4 __attribute__((ext_vector_type(4)));
typedef unsigned u32x4 __attribute__((ext_vector_type(4)));
constexpr int BM = 256, BK = 64, HALF = 128, HTB = HALF * BK * 2  , STAGE_BYTES = 8 * HTB, NXCD = 8, WGM = 8;

__host__ __device__ __forceinline__ int lds_byte(int r, int c) { const int st = (r >> 4) * 2 + (c >> 5), rr = r & 15, cc = c & 31, ob = rr * 64 + cc * 2; return st * 1024 + (ob ^ (((ob >> 9) & 1) << 5)); }
__host__ __device__ __forceinline__ void stage_rc(int b, int& R, int& C) { const int st = b / 1024, sb = b % 1024, swz = sb ^ (((sb >> 9) & 1) << 5); R = (st >> 1) * 16 + swz / 64; C = (st & 1) * 32 + (swz % 64) / 2; }
__host__ __device__ __forceinline__ int perm32(int rho) { const int n = rho >> 4, i = rho & 15; return 8 * (i >> 2) + 4 * n + (i & 3); }

struct Unit { int pm, pn; };
struct Gemm { const bf16_t* A; const bf16_t* Bt; int M, N, K; int lda; };

struct StaticOrder {
    int nM, nN, nwg, G, c;
    __host__ __device__ void init(int M, int N, int G_, int c_) { nM = M / BM; nN = N / BM; nwg = nM * nN; G = G_; c = c_; }
    __host__ __device__ bool next(int i, Unit& u) const {
        const long L = (long)i * G + c; if (L >= nwg) return false;
        int wgid = (int)L; { const int q = nwg / NXCD, r = nwg % NXCD, xcd = wgid % NXCD, off = wgid / NXCD; wgid = (xcd < r ? xcd * (q + 1) : r * (q + 1) + (xcd - r) * q) + off; }
        const int nig = WGM * nN, gid = wgid / nig, fm = gid * WGM, gsz = (nM - fm) < WGM ? (nM - fm) : WGM;
        u.pm = fm + ((wgid % nig) % gsz); u.pn = (wgid % nig) / gsz; return true;
    }
    __device__ __forceinline__ void a_ready(const Unit&) const {}
    __device__ __forceinline__ void done(const Unit&) const {}
};
__device__ __forceinline__ unsigned cvt_pk_bf16(float lo, float hi) { unsigned r; asm volatile("v_cvt_pk_bf16_f32 %0, %1, %2" : "=v"(r) : "v"(lo), "v"(hi)); return r; }
typedef float f32x2 __attribute__((ext_vector_type(2)));
__device__ __forceinline__ f32x2 gelu_pk(f32x2 v) {
    const f32x2 av = __builtin_elementwise_abs(v);
    f32x2 p = av * (-4.88118711e-04f) + 7.19881016e-03f; p = p * av + (-5.21468014e-02f); p = p * av + (-4.59595724e-01f); p = p * av + (-1.15100057e+00f); p = p * av + (-1.0f);
    f32x2 e; e.x = __builtin_amdgcn_exp2f(p.x); e.y = __builtin_amdgcn_exp2f(p.y);
    f32x2 r; r.x = __builtin_fmaxf(v.x, 0.f); r.y = __builtin_fmaxf(v.y, 0.f);
    return r - av * e;
}
template <class Epi, class Sched, bool ALIGN_EPI = false, bool SP2 = false>
__device__ __forceinline__ void gemm_phase(PG8_LAS unsigned char* lds, const Gemm g, const Sched& S, const Epi& E) {
    const int tid = opaque_tid(), wid = __builtin_amdgcn_readfirstlane(tid >> 6), lane = tid & 63, wr = wid >> 2, wc = wid & 3, fr = lane & 15, fq = lane >> 4;
    const int K = g.K, nt = K / BK;
    unsigned voffA[2], voffB[2];
#pragma unroll
    for (int i = 0; i < 2; ++i) { int R, C; stage_rc(tid * 16 + i * 8192, R, C); const int Rb = Epi::PERM ? ((R & ~31) + perm32(R & 31)) : R;
        voffA[i] = (unsigned)(R * g.lda + C) * 2u; voffB[i] = (unsigned)(Rb * K + C) * 2u; }
    const size_t kstep = (size_t)(BK * 2);
    const size_t hstepA = (size_t)HALF * g.lda * 2, hstepB = (size_t)HALF * K * 2;
    const size_t tstepA = 2 * hstepA, tstepB = 2 * hstepB;
    const unsigned ldsw = (unsigned)wid * 1024u;
    const int aoff = lds_byte(wr * 64 + fr, fq * 8), boff = lds_byte(wc * 32 + fr, fq * 8);
#define PG8_SA(b, h) (((b) * 2 + (h)) * HTB)
#define PG8_SB(b, h) ((4 + (b) * 2 + (h)) * HTB)
#define PG8_STAGE(bufoff, gbase, voff) do { _Pragma("unroll") for (int _i = 0; _i < 2; ++_i) \
        __builtin_amdgcn_global_load_lds((const unsigned*)((const char*)(gbase) + (voff)[_i]), (PG8_LAS unsigned*)(lds + (bufoff) + ldsw + _i * 8192), 16, 0, 0); } while (0)
#define PG8_LDA(dst, b, h) do { _Pragma("unroll") for (int m = 0; m < 4; ++m) _Pragma("unroll") for (int k = 0; k < 2; ++k) dst[m][k] = *(const PG8_LAS bf16x8*)(lds + PG8_SA(b, h) + aoff + m * 2048 + k * 1024); } while (0)
#define PG8_LDB(dst, b, h) do { _Pragma("unroll") for (int n = 0; n < 2; ++n) _Pragma("unroll") for (int k = 0; k < 2; ++k) dst[n][k] = *(const PG8_LAS bf16x8*)(lds + PG8_SB(b, h) + boff + n * 2048 + k * 1024); } while (0)
#define PG8_MMA(ai, bj, At, Bt) do { __builtin_amdgcn_s_setprio(1); _Pragma("unroll") for (int m = 0; m < 4; ++m) _Pragma("unroll") for (int n = 0; n < 2; ++n) _Pragma("unroll") for (int k = 0; k < 2; ++k) \
        acc[ai][bj][m][n] = __builtin_amdgcn_mfma_f32_16x16x32_bf16(Bt[n][k], At[m][k], acc[ai][bj][m][n], 0, 0, 0); __builtin_amdgcn_s_setprio(0); } while (0)
#define PG8_WAIT_V(n) asm volatile("s_waitcnt vmcnt(" #n ")" ::: "memory")
#define PG8_WAIT_L(n) asm volatile("s_waitcnt lgkmcnt(" #n ")" ::: "memory")
#define PG8_BAR __builtin_amdgcn_s_barrier()
#define PG8_SCHED __builtin_amdgcn_sched_barrier(0)
    Unit cur, nxt; int ui = 0;
    if (!S.next(0, cur)) return;
    f32x4 acc[2][2][4][2];
#pragma unroll
    for (int a = 0; a < 2; ++a)
#pragma unroll
        for (int b = 0; b < 2; ++b)
#pragma unroll
            for (int m = 0; m < 4; ++m)
#pragma unroll
                for (int n = 0; n < 2; ++n) acc[a][b][m][n] = (f32x4){0.f, 0.f, 0.f, 0.f};
    bf16x8 At[4][2], B0[2][2], B1[2][2];
    const char* cA = (const char*)g.A + (size_t)cur.pm * tstepA; const char* cB = (const char*)g.Bt + (size_t)cur.pn * tstepB;
    S.a_ready(cur);
    E.prefetch(cur, wid, lane);
    if constexpr (SP2) {
        PG8_STAGE(PG8_SB(0, 0), cB, voffB); PG8_STAGE(PG8_SB(0, 1), cB + hstepB, voffB); PG8_STAGE(PG8_SA(0, 0), cA, voffA); PG8_STAGE(PG8_SA(0, 1), cA + hstepA, voffA);
        if (wr == 1) PG8_BAR;
        PG8_WAIT_V(2); PG8_BAR;
        PG8_STAGE(PG8_SB(1, 0), cB + kstep, voffB); PG8_STAGE(PG8_SA(1, 0), cA + kstep, voffA); PG8_STAGE(PG8_SB(1, 1), cB + hstepB + kstep, voffB);
        PG8_WAIT_V(6); PG8_BAR;
    } else {
        PG8_STAGE(PG8_SB(0, 0), cB, voffB); PG8_STAGE(PG8_SA(0, 0), cA, voffA); PG8_STAGE(PG8_SB(0, 1), cB + hstepB, voffB); PG8_STAGE(PG8_SA(0, 1), cA + hstepA, voffA);
        if (wr == 1) PG8_BAR;
        PG8_WAIT_V(4); PG8_BAR;
        PG8_STAGE(PG8_SB(1, 0), cB + kstep, voffB); PG8_STAGE(PG8_SA(1, 0), cA + kstep, voffA); PG8_STAGE(PG8_SB(1, 1), cB + hstepB + kstep, voffB);
        PG8_WAIT_V(6); PG8_BAR;
    }
    for (;;) {
        const bool has_next = S.next(ui + 1, nxt);
        const char* nA = has_next ? (const char*)g.A + (size_t)nxt.pm * tstepA : cA; const char* nB = has_next ? (const char*)g.Bt + (size_t)nxt.pn * tstepB : cB;
        for (int t = 0; t < nt; t += 2) {
            const bool last = (t == nt - 2);
            const char* a1 = cA + (size_t)(t + 1) * kstep;
            const char* a2 = last ? nA : cA + (size_t)(t + 2) * kstep; const char* b2 = last ? nB : cB + (size_t)(t + 2) * kstep;
            const char* a3 = a2 + kstep; const char* b3 = b2 + kstep;
            if (last && has_next) S.a_ready(nxt);
            if constexpr (SP2) {
            PG8_LDB(B0, 0, 0); PG8_LDB(B1, 0, 1); PG8_SCHED; PG8_LDA(At, 0, 0); PG8_STAGE(PG8_SA(1, 1), a1 + hstepA, voffA);
            PG8_WAIT_V(8); PG8_WAIT_L(0); PG8_BAR; PG8_MMA(0, 0, At, B0); PG8_MMA(0, 1, At, B1); PG8_BAR; PG8_SCHED;
            PG8_LDA(At, 0, 1); PG8_STAGE(PG8_SB(0, 0), b2, voffB); PG8_STAGE(PG8_SB(0, 1), b2 + hstepB, voffB); PG8_STAGE(PG8_SA(0, 0), a2, voffA);
            PG8_WAIT_V(8); PG8_WAIT_L(0); PG8_BAR; PG8_MMA(1, 0, At, B0); PG8_MMA(1, 1, At, B1); PG8_BAR; PG8_SCHED;
            PG8_LDB(B0, 1, 0); PG8_LDB(B1, 1, 1); PG8_SCHED; PG8_LDA(At, 1, 0); PG8_STAGE(PG8_SA(0, 1), a2 + hstepA, voffA);
            PG8_WAIT_V(8); PG8_WAIT_L(0); PG8_BAR; PG8_MMA(0, 0, At, B0); PG8_MMA(0, 1, At, B1); PG8_BAR; PG8_SCHED;
            PG8_LDA(At, 1, 1); PG8_STAGE(PG8_SB(1, 0), b3, voffB); PG8_STAGE(PG8_SB(1, 1), b3 + hstepB, voffB); PG8_STAGE(PG8_SA(1, 0), a3, voffA);
            PG8_WAIT_V(8); PG8_WAIT_L(0); PG8_BAR; PG8_MMA(1, 0, At, B0); PG8_MMA(1, 1, At, B1); PG8_BAR; PG8_SCHED;
            } else {
            PG8_LDB(B0, 0, 0); PG8_SCHED; PG8_LDA(At, 0, 0); PG8_STAGE(PG8_SA(1, 1), a1 + hstepA, voffA);
            PG8_WAIT_L(8); PG8_BAR; PG8_WAIT_L(0); PG8_MMA(0, 0, At, B0); PG8_BAR; PG8_SCHED;
            PG8_LDB(B1, 0, 1); PG8_STAGE(PG8_SB(0, 0), b2, voffB);
            PG8_BAR; PG8_WAIT_L(0); PG8_MMA(0, 1, At, B1); PG8_BAR;
            PG8_LDA(At, 0, 1); PG8_STAGE(PG8_SA(0, 0), a2, voffA);
            PG8_BAR; PG8_WAIT_L(0); PG8_MMA(1, 0, At, B0); PG8_BAR; PG8_SCHED;
            PG8_STAGE(PG8_SB(0, 1), b2 + hstepB, voffB);
            PG8_WAIT_V(6); PG8_BAR; PG8_MMA(1, 1, At, B1); PG8_BAR;
            PG8_LDB(B0, 1, 0); PG8_SCHED; PG8_LDA(At, 1, 0); PG8_STAGE(PG8_SA(0, 1), a2 + hstepA, voffA);
            PG8_WAIT_L(8); PG8_BAR; PG8_WAIT_L(0); PG8_MMA(0, 0, At, B0); PG8_BAR; PG8_SCHED;
            PG8_LDB(B1, 1, 1); PG8_STAGE(PG8_SB(1, 0), b3, voffB);
            PG8_BAR; PG8_WAIT_L(0); PG8_MMA(0, 1, At, B1); PG8_BAR;
            PG8_LDA(At, 1, 1); PG8_STAGE(PG8_SA(1, 0), a3, voffA);
            PG8_BAR; PG8_WAIT_L(0); PG8_MMA(1, 0, At, B0); PG8_BAR; PG8_SCHED;
            PG8_STAGE(PG8_SB(1, 1), b3 + hstepB, voffB);
            PG8_WAIT_V(6); PG8_BAR; PG8_MMA(1, 1, At, B1); PG8_BAR;
            }
        }
        if constexpr (ALIGN_EPI) { if (wr == 0) PG8_BAR; }
        if constexpr (!Epi::AFTER_DRAIN) { E(acc, cur, wr, wc, fr, fq); S.done(cur); }
        if (!has_next) break;
#pragma unroll
        for (int a = 0; a < 2; ++a)
#pragma unroll
            for (int b = 0; b < 2; ++b)
#pragma unroll
                for (int m = 0; m < 4; ++m)
#pragma unroll
                    for (int n = 0; n < 2; ++n) acc[a][b][m][n] = (f32x4){0.f, 0.f, 0.f, 0.f};
        cur = nxt; cA = nA; cB = nB; ++ui;
        E.prefetch(cur, wid, lane);
        if constexpr (ALIGN_EPI) { if (wr == 1) PG8_BAR; }
    }
    PG8_WAIT_V(0);
    if constexpr (!ALIGN_EPI) { if (wr == 0) PG8_BAR; }
    PG8_BAR;
    if constexpr (Epi::AFTER_DRAIN) { E.fused(acc, cur, wr, wc, fr, fq, lds, wid, lane); S.done(cur); }
#undef PG8_SA
#undef PG8_SB
#undef PG8_STAGE
#undef PG8_LDA
#undef PG8_LDB
#undef PG8_MMA
#undef PG8_WAIT_V
#undef PG8_WAIT_L
#undef PG8_BAR
#undef PG8_SCHED
}
}
constexpr int BATCH = 8, SEQ = 4096, T = BATCH * SEQ, D = 1024, FF = 4096, AW = 2048, NGRP = 8, GDIM = 256, CHUNK = 128;
constexpr int NH = 16, NKV = 4, HD = 64, KVD = NKV * HD;
constexpr float EPS = 1e-6f;
constexpr float LOG2E = 1.4426950408889634f;
constexpr float QSCALE = 0.125f * LOG2E;

namespace pg8 {
typedef short s16x4 __attribute__((ext_vector_type(4)));
__device__ __forceinline__ void ssq_prefetch(PG8_LAS float* tab, const float* ssq, int tile, int wid, int lane) {
#pragma unroll
    for (int i = 0; i < 2; ++i) { const int j = 2 * wid + i;
        const char* g = (const char*)ssq + (size_t)(tile * BM + 16 * j) * 64 + lane * 16;
        __builtin_amdgcn_global_load_lds((const unsigned*)g, (PG8_LAS unsigned*)((PG8_LAS unsigned char*)tab + j * 1024), 16, 0, 0); }
}
__device__ __forceinline__ void row_rstd_lds(float (&rs)[2][4], const PG8_LAS float* tab, int r0, int fq, float mul) {
    f32x4 p[2][4];
#pragma unroll
    for (int ai = 0; ai < 2; ++ai)
#pragma unroll
        for (int m = 0; m < 4; ++m) p[ai][m] = *(const PG8_LAS f32x4*)(tab + (r0 + ai * HALF + m * 16) * 16 + 4 * fq);
    float s[2][4];
#pragma unroll
    for (int ai = 0; ai < 2; ++ai)
#pragma unroll
        for (int m = 0; m < 4; ++m) s[ai][m] = (p[ai][m][0] + p[ai][m][1]) + (p[ai][m][2] + p[ai][m][3]);
#pragma unroll
    for (int ai = 0; ai < 2; ++ai)
#pragma unroll
        for (int m = 0; m < 4; ++m) s[ai][m] += __shfl_xor(s[ai][m], 16);
#pragma unroll
    for (int ai = 0; ai < 2; ++ai)
#pragma unroll
        for (int m = 0; m < 4; ++m) s[ai][m] += __shfl_xor(s[ai][m], 32);
#pragma unroll
    for (int ai = 0; ai < 2; ++ai)
#pragma unroll
        for (int m = 0; m < 4; ++m) rs[ai][m] = mul * __builtin_amdgcn_rsqf(s[ai][m] * (1.0f / 1024.0f) + 1e-6f);
}
__device__ __forceinline__ void row_rstd(float (&rs)[2][4], const float* ssq, int row0, int fq, float mul) {
    f32x4 p[2][4];
#pragma unroll
    for (int ai = 0; ai < 2; ++ai)
#pragma unroll
        for (int m = 0; m < 4; ++m) p[ai][m] = *(const f32x4*)(ssq + (size_t)(row0 + ai * HALF + m * 16) * 16 + 4 * fq);
    __builtin_amdgcn_sched_barrier(0);
    float s[2][4];
#pragma unroll
    for (int ai = 0; ai < 2; ++ai)
#pragma unroll
        for (int m = 0; m < 4; ++m) s[ai][m] = (p[ai][m][0] + p[ai][m][1]) + (p[ai][m][2] + p[ai][m][3]);
#pragma unroll
    for (int ai = 0; ai < 2; ++ai)
#pragma unroll
        for (int m = 0; m < 4; ++m) s[ai][m] += __shfl_xor(s[ai][m], 16);
#pragma unroll
    for (int ai = 0; ai < 2; ++ai)
#pragma unroll
        for (int m = 0; m < 4; ++m) s[ai][m] += __shfl_xor(s[ai][m], 32);
#pragma unroll
    for (int ai = 0; ai < 2; ++ai)
#pragma unroll
        for (int m = 0; m < 4; ++m) rs[ai][m] = mul * __builtin_amdgcn_rsqf(s[ai][m] * (1.0f / 1024.0f) + 1e-6f);
    __builtin_amdgcn_sched_barrier(0);
}
template <int ACT, int MODE = 0, bool STATS = false> struct EpiRowAct {
    static constexpr bool PERM = true, AFTER_DRAIN = false;
    bf16_t* O; int ldc; const float* ssq; float sc; bf16_t* O2; int split; float* vsum; float* vsq; PG8_LAS float* tab;
    __device__ __forceinline__ void prefetch(const Unit& u, int wid, int lane) const { ssq_prefetch(tab, ssq, u.pm, wid, lane); }
    __device__ __forceinline__ void operator()(const f32x4 (&acc)[2][2][4][2], const Unit& u, int wr, int wc, int fr, int fq) const {
        const int row0 = u.pm * BM + wr * 64 + fr; int colt = u.pn * BM; bf16_t* base = O; const bool second = STATS && (colt >= split);
        if (STATS) { if (second) { base = O2; colt -= split; } }
        const int col0 = colt + wc * 32 + 8 * fq;
        float pss[2][4], pqs[2][4];
        float rs[2][4]; if (MODE != 1) { row_rstd_lds(rs, tab, wr * 64 + fr, fq, sc); asm volatile("s_waitcnt lgkmcnt(0)\n\ts_barrier" ::: "memory");   } else {
#pragma unroll
            for (int ai = 0; ai < 2; ++ai)
#pragma unroll
                for (int m = 0; m < 4; ++m) rs[ai][m] = sc; }
#pragma unroll
        for (int ai = 0; ai < 2; ++ai)
#pragma unroll
            for (int m = 0; m < 4; ++m) { const int row = row0 + ai * HALF + m * 16; bf16_t* rowp = base + (size_t)row * ldc + col0; const float r = rs[ai][m]; float ps = 0.f, pq = 0.f;
#pragma unroll
                for (int bj = 0; bj < 2; ++bj) { f32x4 v0 = acc[ai][bj][m][0] * r, v1 = acc[ai][bj][m][1] * r;
                    if (ACT == 1) { f32x2 a = gelu_pk((f32x2){v0[0], v0[1]}), b = gelu_pk((f32x2){v0[2], v0[3]}), c = gelu_pk((f32x2){v1[0], v1[1]}), d = gelu_pk((f32x2){v1[2], v1[3]});
                        v0 = (f32x4){a.x, a.y, b.x, b.y}; v1 = (f32x4){c.x, c.y, d.x, d.y}; }
                    if (ACT == 2) {
#pragma unroll
                        for (int e = 0; e < 4; ++e) { v0[e] = fmaxf(v0[e], 0.f); v1[e] = fmaxf(v1[e], 0.f); }
                        v0 = v0 * v0; v1 = v1 * v1; }
                    if (STATS) { ps += (v0[0] + v0[1]) + (v0[2] + v0[3]) + (v1[0] + v1[1]) + (v1[2] + v1[3]);
                        pq += (v0[0] * v0[0] + v0[1] * v0[1]) + (v0[2] * v0[2] + v0[3] * v0[3]) + (v1[0] * v1[0] + v1[1] * v1[1]) + (v1[2] * v1[2] + v1[3] * v1[3]); }
                    u32x4 w; w.x = cvt_pk_bf16(v0[0], v0[1]); w.y = cvt_pk_bf16(v0[2], v0[3]); w.z = cvt_pk_bf16(v1[0], v1[1]); w.w = cvt_pk_bf16(v1[2], v1[3]);
                    if (MODE != 2) *(u32x4*)(rowp + bj * HALF) = w; else asm volatile("" :: "v"(w)); }
                if (STATS) { pss[ai][m] = ps; pqs[ai][m] = pq; } }
        if (STATS) { if (second) {
#pragma unroll
            for (int ai = 0; ai < 2; ++ai)
#pragma unroll
                for (int m = 0; m < 4; ++m) { pss[ai][m] += __shfl_xor(pss[ai][m], 16); pqs[ai][m] += __shfl_xor(pqs[ai][m], 16); }
#pragma unroll
            for (int ai = 0; ai < 2; ++ai)
#pragma unroll
                for (int m = 0; m < 4; ++m) { pss[ai][m] += __shfl_xor(pss[ai][m], 32); pqs[ai][m] += __shfl_xor(pqs[ai][m], 32); }
            if (fq == 0) {
#pragma unroll
                for (int ai = 0; ai < 2; ++ai)
#pragma unroll
                    for (int m = 0; m < 4; ++m) { const size_t si = (size_t)(row0 + ai * HALF + m * 16) * 32 + (colt >> 8) * 4 + wc; vsum[si] = pss[ai][m]; vsq[si] = pqs[ai][m]; } } } }
    }
};
template <int ACT, bool STATS> struct EpiColAct {
    static constexpr bool PERM = true, AFTER_DRAIN = false;
    bf16_t* O; int ldc; const float* ssq; float* vsum; float* vsq;
    __device__ __forceinline__ void prefetch(const Unit&, int, int) const {}
    __device__ __forceinline__ void operator()(const f32x4 (&acc)[2][2][4][2], const Unit& u, int wr, int wc, int fr, int fq) const {
        const int row0 = u.pm * BM + wr * 64 + fr, col0 = u.pn * BM + wc * 32 + 8 * fq;
        float cs[2][8];
#pragma unroll
        for (int bj = 0; bj < 2; ++bj)
#pragma unroll
            for (int j = 0; j < 8; ++j) { float s = ssq[(size_t)(col0 + bj * HALF + j) * 16 + fr];
                s += __shfl_xor(s, 1); s += __shfl_xor(s, 2); s += __shfl_xor(s, 4); s += __shfl_xor(s, 8);
                cs[bj][j] = __builtin_amdgcn_rsqf(s * (1.0f / 1024.0f) + 1e-6f); }
        float psum[2][8], psq[2][8];
#pragma unroll
        for (int bj = 0; bj < 2; ++bj)
#pragma unroll
            for (int j = 0; j < 8; ++j) { psum[bj][j] = 0.f; psq[bj][j] = 0.f; }
#pragma unroll
        for (int ai = 0; ai < 2; ++ai)
#pragma unroll
            for (int m = 0; m < 4; ++m) { bf16_t* rowp = O + (size_t)(row0 + ai * HALF + m * 16) * ldc + col0;
#pragma unroll
                for (int bj = 0; bj < 2; ++bj) { f32x4 v0 = acc[ai][bj][m][0], v1 = acc[ai][bj][m][1];
#pragma unroll
                    for (int e = 0; e < 4; ++e) { v0[e] *= cs[bj][e]; v1[e] *= cs[bj][4 + e]; }
                    if (ACT == 1) { f32x2 a = gelu_pk((f32x2){v0[0], v0[1]}), b = gelu_pk((f32x2){v0[2], v0[3]}), c = gelu_pk((f32x2){v1[0], v1[1]}), d = gelu_pk((f32x2){v1[2], v1[3]});
                        v0 = (f32x4){a.x, a.y, b.x, b.y}; v1 = (f32x4){c.x, c.y, d.x, d.y}; }
                    if (STATS) {
#pragma unroll
                        for (int e = 0; e < 4; ++e) { psum[bj][e] += v0[e]; psq[bj][e] += v0[e] * v0[e]; psum[bj][4 + e] += v1[e]; psq[bj][4 + e] += v1[e] * v1[e]; } }
                    u32x4 w; w.x = cvt_pk_bf16(v0[0], v0[1]); w.y = cvt_pk_bf16(v0[2], v0[3]); w.z = cvt_pk_bf16(v1[0], v1[1]); w.w = cvt_pk_bf16(v1[2], v1[3]);
                    *(u32x4*)(rowp + bj * HALF) = w; } }
        if (STATS) {
#pragma unroll
            for (int bj = 0; bj < 2; ++bj)
#pragma unroll
                for (int j = 0; j < 8; ++j) { float s = psum[bj][j], q = psq[bj][j];
                    s += __shfl_xor(s, 1); s += __shfl_xor(s, 2); s += __shfl_xor(s, 4); s += __shfl_xor(s, 8);
                    q += __shfl_xor(q, 1); q += __shfl_xor(q, 2); q += __shfl_xor(q, 4); q += __shfl_xor(q, 8);
                    if (fr == 0) { const size_t si = (size_t)(col0 + bj * HALF + j) * 16 + u.pm * 2 + wr; vsum[si] = s; vsq[si] = q; } }
        }
    }
};
struct EpiResid {
    static constexpr bool PERM = true, AFTER_DRAIN = false;
    bf16_t* hbf; float* ssq; float* out32;
    __device__ __forceinline__ void prefetch(const Unit&, int, int) const {}
    __device__ __forceinline__ void operator()(const f32x4 (&acc)[2][2][4][2], const Unit& u, int wr, int wc, int fr, int fq) const {
        const int row0 = u.pm * BM + wr * 64 + fr, col0 = u.pn * BM + wc * 32 + 8 * fq;
        u32x4 pre[4][2]; float qs[2][4];
#pragma unroll
        for (int m = 0; m < 4; ++m) { const size_t off = (size_t)(row0 + m * 16) * 1024 + col0;
#pragma unroll
            for (int bj = 0; bj < 2; ++bj) pre[m][bj] = *(const u32x4*)(hbf + off + bj * HALF); }
#pragma unroll
        for (int ai = 0; ai < 2; ++ai)
#pragma unroll
            for (int m = 0; m < 4; ++m) { const int row = row0 + ai * HALF + m * 16; const size_t off = (size_t)row * 1024 + col0; float q = 0.f;
#pragma unroll
                for (int bj = 0; bj < 2; ++bj) { const u32x4 r = pre[m][bj];
                    const f32x4 b0 = (f32x4){__uint_as_float(r.x << 16), __uint_as_float(r.x & 0xffff0000u), __uint_as_float(r.y << 16), __uint_as_float(r.y & 0xffff0000u)};
                    const f32x4 b1 = (f32x4){__uint_as_float(r.z << 16), __uint_as_float(r.z & 0xffff0000u), __uint_as_float(r.w << 16), __uint_as_float(r.w & 0xffff0000u)};
                    const f32x4 v0 = acc[ai][bj][m][0] + b0, v1 = acc[ai][bj][m][1] + b1;
                    if (out32) { *(f32x4*)(out32 + off + bj * HALF) = v0; *(f32x4*)(out32 + off + bj * HALF + 4) = v1; }
                    u32x4 w; w.x = cvt_pk_bf16(v0[0], v0[1]); w.y = cvt_pk_bf16(v0[2], v0[3]); w.z = cvt_pk_bf16(v1[0], v1[1]); w.w = cvt_pk_bf16(v1[2], v1[3]);
                    *(u32x4*)(hbf + off + bj * HALF) = w;
                    q += (v0[0] * v0[0] + v0[1] * v0[1]) + (v0[2] * v0[2] + v0[3] * v0[3]) + (v1[0] * v1[0] + v1[1] * v1[1]) + (v1[2] * v1[2] + v1[3] * v1[3]); }
                qs[ai][m] = q;
                if (ai == 0) {
#pragma unroll
                    for (int bj = 0; bj < 2; ++bj) pre[m][bj] = *(const u32x4*)(hbf + off + (size_t)HALF * 1024 + bj * HALF);
                    asm volatile("" ::: "memory"); } }
#pragma unroll
        for (int ai = 0; ai < 2; ++ai)
#pragma unroll
            for (int m = 0; m < 4; ++m) qs[ai][m] += __shfl_xor(qs[ai][m], 16);
#pragma unroll
        for (int ai = 0; ai < 2; ++ai)
#pragma unroll
            for (int m = 0; m < 4; ++m) qs[ai][m] += __shfl_xor(qs[ai][m], 32);
        if (fq == 0) {
#pragma unroll
            for (int ai = 0; ai < 2; ++ai)
#pragma unroll
                for (int m = 0; m < 4; ++m) ssq[(size_t)(row0 + ai * HALF + m * 16) * 16 + u.pn * 4 + wc] = qs[ai][m]; }
    }
};
struct EpiNull {
    static constexpr bool PERM = true, AFTER_DRAIN = false;
    __device__ __forceinline__ void prefetch(const Unit&, int, int) const {}
    __device__ __forceinline__ void operator()(const f32x4 (&acc)[2][2][4][2], const Unit& u, int wr, int wc, int fr, int fq) const {
#pragma unroll
        for (int ai = 0; ai < 2; ++ai)
#pragma unroll
            for (int bj = 0; bj < 2; ++bj)
#pragma unroll
                for (int m = 0; m < 4; ++m)
#pragma unroll
                    for (int n = 0; n < 2; ++n) asm volatile("" :: "v"(acc[ai][bj][m][n]));
    }
};
}

constexpr size_t MiB = 1u << 20;
constexpr size_t WS_WIN = 0, WS_WOUT = 16 * MiB, WS_W1 = 24 * MiB, WS_W2 = 56 * MiB, WS_WQ = 88 * MiB, WS_WO = 92 * MiB, WS_WKV = 96 * MiB, WS_WC = 97 * MiB, WS_BIAS = 98 * MiB;
constexpr size_t WS_CTL = 99 * MiB, CTL_ZERO_BYTES = 32768;
constexpr size_t WS_SSQ = 100 * MiB, WS_VSUM = 102 * MiB, WS_VSQ = 106 * MiB, WS_HBF = 112 * MiB, WS_K = 176 * MiB, WS_VT = 192 * MiB, WS_R1 = 208 * MiB, WS_END = 464 * MiB;
constexpr int LDS_BYTES = 131072 + 256 + 16384;
constexpr int NTHREADS = 512;
constexpr int RP = 4096;

#define LAS __attribute__((address_space(3)))
typedef unsigned short bf16;
typedef unsigned u32x4 __attribute__((ext_vector_type(4)));
typedef unsigned u32x2 __attribute__((ext_vector_type(2)));
typedef float f32x4 __attribute__((ext_vector_type(4)));
typedef short bf16x8 __attribute__((ext_vector_type(8)));
typedef short s16x4 __attribute__((ext_vector_type(4)));

__device__ __forceinline__ unsigned pk2(float lo, float hi) { return pg8::cvt_pk_bf16(lo, hi); }
__device__ __forceinline__ float bf_lo(unsigned w) { return __uint_as_float(w << 16); }
__device__ __forceinline__ float bf_hi(unsigned w) { return __uint_as_float(w & 0xffff0000u); }
__device__ __forceinline__ float wave_sum(float v) {
#pragma unroll
    for (int o = 1; o < 64; o <<= 1) v += __shfl_xor(v, o);
    return v;
}

__device__ __forceinline__ void transpose_item(const float* W, int K, int N, const float* g, bf16* WT, LAS float* scr, int item, int lane) {
    const int nblk = N / 32, kb = item / nblk, nb = item % nblk, k0 = 64 * kb, n0 = 32 * nb;
    f32x4 w[8]; float gk[8];
#pragma unroll
    for (int i = 0; i < 8; ++i) { const int kk = 8 * i + (lane >> 3); w[i] = *(const f32x4*)(W + (size_t)(k0 + kk) * N + n0 + (lane & 7) * 4); gk[i] = g ? g[k0 + kk] : 1.0f; }
#pragma unroll
    for (int i = 0; i < 8; ++i) { const int kk = 8 * i + (lane >> 3); LAS float* d = scr + kk * 33 + (lane & 7) * 4;
        d[0] = w[i][0] * gk[i]; d[1] = w[i][1] * gk[i]; d[2] = w[i][2] * gk[i]; d[3] = w[i][3] * gk[i]; }
    asm volatile("s_waitcnt lgkmcnt(0)" ::: "memory");
    const int c = lane & 7;
#pragma unroll
    for (int j = 0; j < 4; ++j) { const int n = (lane >> 3) + 8 * j; const LAS float* s = scr + (8 * c) * 33 + n;
        u32x4 o; o.x = pk2(s[0 * 33], s[1 * 33]); o.y = pk2(s[2 * 33], s[3 * 33]); o.z = pk2(s[4 * 33], s[5 * 33]); o.w = pk2(s[6 * 33], s[7 * 33]);
        *(u32x4*)(WT + (size_t)(n0 + n) * K + k0 + 8 * c) = o; }
    asm volatile("s_waitcnt lgkmcnt(0)" ::: "memory");
}

struct Args {
    const float* x; const float* mix_g; const float* ffn_g; const float* a_w_in; const float* a_ln_g; const float* a_w_s; const float* a_b_s; const float* a_w_out;
    const float* kv_g; const float* w_k; const float* w_v; const float* b_w_q; const float* b_sinks; const float* b_w_o; const float* rel_bias; const float* ffn_w1; const float* ffn_w2; const float* final_g;
    float* out; unsigned char* ws;
};

__device__ __forceinline__ void prologue(const Args& a, LAS unsigned char* lds) {
    const int tid = opaque_tid(), lane = tid & 63, wave = tid >> 6;
    LAS float* scr = (LAS float*)(lds + wave * 16384);
    const int gw = blockIdx.x * 8 + wave, NGW = gridDim.x * 8;
    unsigned char* ws = a.ws;
    constexpr int I_IN = (D / 64) * (4096 / 32), I_OUT = (AW / 64) * (D / 32), I_1 = (D / 64) * (FF / 32), I_2 = (FF / 64) * (D / 32), I_Q = (D / 64) * (D / 32), I_KV = (D / 64) * (KVD / 32);
    constexpr int NITEMS = 2 * I_IN + 2 * I_OUT + 4 * I_1 + 4 * I_2 + 2 * I_Q + 2 * I_Q + 2 * I_KV;
    for (int it = gw; it < NITEMS; it += NGW) {
        int r = it;
#define TR(CNT, W, Kd, Nd, G, DST) if (r < (CNT)) { transpose_item((W), (Kd), (Nd), (G), (bf16*)(DST), scr, r, lane); continue; } r -= (CNT);
        TR(I_IN, a.a_w_in, D, 4096, a.mix_g, ws + WS_WIN)
        TR(I_IN, a.a_w_in + (size_t)D * 4096, D, 4096, a.mix_g + D, ws + WS_WIN + (size_t)D * 4096 * 2)
        TR(I_OUT, a.a_w_out, AW, D, nullptr, ws + WS_WOUT)
        TR(I_OUT, a.a_w_out + (size_t)AW * D, AW, D, nullptr, ws + WS_WOUT + (size_t)AW * D * 2)
        TR(I_1, a.ffn_w1 + 0 * (size_t)D * FF, D, FF, a.ffn_g + 0 * D, ws + WS_W1 + 0 * (size_t)D * FF * 2)
        TR(I_1, a.ffn_w1 + 1 * (size_t)D * FF, D, FF, a.ffn_g + 1 * D, ws + WS_W1 + 1 * (size_t)D * FF * 2)
        TR(I_1, a.ffn_w1 + 2 * (size_t)D * FF, D, FF, a.ffn_g + 2 * D, ws + WS_W1 + 2 * (size_t)D * FF * 2)
        TR(I_1, a.ffn_w1 + 3 * (size_t)D * FF, D, FF, a.ffn_g + 3 * D, ws + WS_W1 + 3 * (size_t)D * FF * 2)
        TR(I_2, a.ffn_w2 + 0 * (size_t)D * FF, FF, D, nullptr, ws + WS_W2 + 0 * (size_t)D * FF * 2)
        TR(I_2, a.ffn_w2 + 1 * (size_t)D * FF, FF, D, nullptr, ws + WS_W2 + 1 * (size_t)D * FF * 2)
        TR(I_2, a.ffn_w2 + 2 * (size_t)D * FF, FF, D, nullptr, ws + WS_W2 + 2 * (size_t)D * FF * 2)
        TR(I_2, a.ffn_w2 + 3 * (size_t)D * FF, FF, D, nullptr, ws + WS_W2 + 3 * (size_t)D * FF * 2)
        TR(I_Q, a.b_w_q, D, D, a.mix_g + 2 * D, ws + WS_WQ)
        TR(I_Q, a.b_w_q + (size_t)D * D, D, D, a.mix_g + 3 * D, ws + WS_WQ + (size_t)D * D * 2)
        TR(I_Q, a.b_w_o, D, D, nullptr, ws + WS_WO)
        TR(I_Q, a.b_w_o + (size_t)D * D, D, D, nullptr, ws + WS_WO + (size_t)D * D * 2)
        TR(I_KV, a.w_k, D, KVD, a.kv_g, ws + WS_WKV)
        TR(I_KV, a.w_v, D, KVD, a.kv_g, ws + WS_WKV + (size_t)D * KVD * 2)
#undef TR
    }
    {
        bf16* wc = (bf16*)(ws + WS_WC);
        const int gt = blockIdx.x * NTHREADS + tid, NT = gridDim.x * NTHREADS;
        for (int i = gt; i < 2 * NGRP * CHUNK * CHUNK / 2; i += NT) {
            const int e = 2 * i, col = e & 127, row = (e >> 7) & 127;
            const float w0 = (col <= row) ? a.a_w_s[e] : 0.f, w1 = (col + 1 <= row) ? a.a_w_s[e + 1] : 0.f;
            ((unsigned*)wc)[i] = pk2(w0, w1);
        }
        float* b2 = (float*)(ws + WS_BIAS);
        for (int i = gt; i < NH * 160; i += NT) {
            const int h = i / 160, d = i % 160 - 16; float val = -1e30f;
            if (d >= 0 && d < 128) { int bucket;
                if (d < 16) bucket = d;
                else { const float lr = logf((float)d / 16.0f) / logf(8.0f); int l = 16 + (int)(lr * 16.0f); bucket = l < 31 ? l : 31; }
                val = a.rel_bias[bucket * NH + h] * LOG2E; }
            b2[i] = val;
        }
    }
    {
        bf16* hbf = (bf16*)(ws + WS_HBF); float* ssq = (float*)(ws + WS_SSQ);
        for (int m0 = gw; m0 < T; m0 += 4 * NGW) {
            f32x4 v[4][4];
#pragma unroll
            for (int r = 0; r < 4; ++r) { const int m = m0 + r * NGW; if (m < T) { const f32x4* xr = (const f32x4*)(a.x + (size_t)m * D) + lane;
#pragma unroll
                    for (int j = 0; j < 4; ++j) v[r][j] = xr[64 * j]; } }
#pragma unroll
            for (int r = 0; r < 4; ++r) { const int m = m0 + r * NGW; if (m < T) { float s = 0.f;
#pragma unroll
                    for (int j = 0; j < 4; ++j) s += (v[r][j][0] * v[r][j][0] + v[r][j][1] * v[r][j][1]) + (v[r][j][2] * v[r][j][2] + v[r][j][3] * v[r][j][3]);
                    s = wave_sum(s);
                    u32x2* o8 = (u32x2*)(hbf + (size_t)m * D) + lane;
#pragma unroll
                    for (int j = 0; j < 4; ++j) { u32x2 w; w.x = pk2(v[r][j][0], v[r][j][1]); w.y = pk2(v[r][j][2], v[r][j][3]); o8[64 * j] = w; }
                    if (lane < 16) ssq[(size_t)m * 16 + lane] = (lane == 0) ? s : 0.f; } }
        }
    }
}

__device__ __forceinline__ int sgu_chunk(int unit, int G) {
    if (G != 256) return unit >> 3;
    const int i = unit >> 8, b0 = unit & 255, x = b0 & 7, r = b0 >> 3;
    return 32 * x + ((i < 4) ? 16 : 0) + (r >> 3) + 4 * (i & 3);
}
__device__ __forceinline__ int sgu_group(int unit, int G) { return (G != 256) ? (unit & 7) : (((unit & 255) >> 3) & 7); }
__device__ __forceinline__ s16x4 lds_tr(const LAS unsigned char* p) { typedef short v4i16_t __attribute__((ext_vector_type(4))); return __builtin_bit_cast(s16x4, __builtin_amdgcn_ds_read_tr16_b64_v4i16((LAS v4i16_t*)p)); }
__device__ __forceinline__ void sgu_phase(LAS unsigned char* lds, const bf16* WcBf, const float* lng, const float* bs, const bf16* v, bf16* u, const float* vsum, const float* vsq, bf16* dst, size_t dmask) {
    const int tid = opaque_tid(), wid = tid >> 6, lane = tid & 63, fr = lane & 15, fq = lane >> 4, wr = wid >> 2, wc = wid & 3;
    constexpr int BST = 576;
    LAS unsigned char* As = lds;
    LAS unsigned char* Bs = lds + 34816;
    LAS float* MU = (LAS float*)(lds + 34816 + 128 * BST); LAS float* RS = MU + 2048;
    const int NU = (T / CHUNK) * NGRP, G = gridDim.x, b0 = blockIdx.x;
    const int cnt = (b0 < NU) ? (NU - b0 + G - 1) / G : 0;
    const int c8 = (tid & 31) * 8, rbase = tid >> 5;
    int gprev = -1; float gc[8], bi[4];
    u32x4 rawB[8];
    for (int i0 = 0; i0 < cnt; i0 += 16) {
        const int c16 = (cnt - i0) < 16 ? (cnt - i0) : 16;
        __syncthreads();
        for (int idx = tid; idx < c16 * 128; idx += NTHREADS) { const int ui = idx >> 7, tk = idx & 127, n = sgu_chunk(b0 + G * (i0 + ui), G);
            const f32x4* ps = (const f32x4*)(vsum + (size_t)(n * CHUNK + tk) * 32); const f32x4* pq = (const f32x4*)(vsq + (size_t)(n * CHUNK + tk) * 32); float sm = 0.f, q = 0.f;
#pragma unroll
            for (int i = 0; i < 8; ++i) { const f32x4 a = ps[i], b = pq[i]; sm += (a[0] + a[1]) + (a[2] + a[3]); q += (b[0] + b[1]) + (b[2] + b[3]); }
            const float mean = sm * (1.0f / 2048.0f); float var = q * (1.0f / 2048.0f) - mean * mean; var = var > 0.f ? var : 0.f;
            MU[idx] = mean; RS[idx] = 1.0f / sqrtf(var + EPS); }
        {
            const int unit = b0 + G * i0, n = sgu_chunk(unit, G), g = sgu_group(unit, G);
#pragma unroll
            for (int i = 0; i < 8; ++i) rawB[i] = *(const u32x4*)(v + (size_t)(n * CHUNK + rbase + 16 * i) * RP + g * GDIM + c8);
        }
        for (int ii = 0; ii < c16; ++ii) {
            const int unit = b0 + G * (i0 + ii), n = sgu_chunk(unit, G), g = sgu_group(unit, G), tok0 = n * CHUNK;
            if (g != gprev) {
                gprev = g;
                const bf16* Ag = WcBf + (size_t)g * CHUNK * CHUNK;
#pragma unroll
                for (int i = 0; i < 4; ++i) { const int q = tid + 512 * i, r = q >> 4, cc = (q & 15) * 8; const u32x4 w = *(const u32x4*)(Ag + r * 128 + cc); *(LAS u32x4*)(As + r * 272 + cc * 2) = w; }
                const f32x4 g0 = *(const f32x4*)(lng + g * GDIM + c8), g1 = *(const f32x4*)(lng + g * GDIM + c8 + 4);
                gc[0] = g0[0]; gc[1] = g0[1]; gc[2] = g0[2]; gc[3] = g0[3]; gc[4] = g1[0]; gc[5] = g1[1]; gc[6] = g1[2]; gc[7] = g1[3];
#pragma unroll
                for (int m = 0; m < 4; ++m) bi[m] = bs[g * CHUNK + 64 * wr + 16 * m + fr];
            }
            if (ii == 0) __syncthreads();
#pragma unroll
            for (int i = 0; i < 8; ++i) { const int r = rbase + 16 * i; const u32x4 raw = rawB[i]; const float mu = MU[ii * 128 + r], rs = RS[ii * 128 + r];
                float y[8]; y[0] = bf_lo(raw.x); y[1] = bf_hi(raw.x); y[2] = bf_lo(raw.y); y[3] = bf_hi(raw.y); y[4] = bf_lo(raw.z); y[5] = bf_hi(raw.z); y[6] = bf_lo(raw.w); y[7] = bf_hi(raw.w);
#pragma unroll
                for (int j = 0; j < 8; ++j) y[j] = (y[j] - mu) * (rs * gc[j]);
                u32x4 w; w.x = pk2(y[0], y[1]); w.y = pk2(y[2], y[3]); w.z = pk2(y[4], y[5]); w.w = pk2(y[6], y[7]);
                *(LAS u32x4*)(Bs + r * BST + c8 * 2) = w; }
            __syncthreads();
            u32x4 ureg[4][2];
#pragma unroll
            for (int m = 0; m < 4; ++m)
#pragma unroll
                for (int p = 0; p < 2; ++p) ureg[m][p] = *(const u32x4*)(u + (size_t)(tok0 + 64 * wr + 16 * m + fr) * RP + g * GDIM + 64 * wc + 32 * p + 8 * fq);
            if (ii + 1 < c16) { const int un = unit + G, nn = sgu_chunk(un, G), gn = sgu_group(un, G);
#pragma unroll
                for (int i = 0; i < 8; ++i) rawB[i] = *(const u32x4*)(v + (size_t)(nn * CHUNK + rbase + 16 * i) * RP + gn * GDIM + c8); }
            f32x4 acc[4][4];
#pragma unroll
            for (int m = 0; m < 4; ++m)
#pragma unroll
                for (int nn = 0; nn < 4; ++nn) acc[m][nn] = (f32x4){0.f, 0.f, 0.f, 0.f};
            const int nk = wr ? 4 : 2;
            const LAS unsigned char* trb = Bs + (8 * fq + (fr >> 2)) * BST + (64 * wc + 8 * (fr & 3)) * 2;
            for (int kk = 0; kk < nk; ++kk) {
                bf16x8 af[4], bfr[4];
#pragma unroll
                for (int m = 0; m < 4; ++m) af[m] = *(const LAS bf16x8*)(As + (64 * wr + 16 * m + fr) * 272 + kk * 64 + fq * 16);
#pragma unroll
                for (int nn = 0; nn < 4; ++nn) { const LAS unsigned char* p0 = trb + kk * 32 * BST + (32 * (nn >> 1) + 4 * (nn & 1)) * 2;
                    const s16x4 lo = lds_tr(p0), hi = lds_tr(p0 + 4 * BST);
                    bfr[nn] = (bf16x8){lo[0], lo[1], lo[2], lo[3], hi[0], hi[1], hi[2], hi[3]}; }
#pragma unroll
                for (int m = 0; m < 4; ++m)
#pragma unroll
                    for (int nn = 0; nn < 4; ++nn) acc[m][nn] = __builtin_amdgcn_mfma_f32_16x16x32_bf16(bfr[nn], af[m], acc[m][nn], 0, 0, 0);
            }
#pragma unroll
            for (int m = 0; m < 4; ++m) { const int i = 64 * wr + 16 * m + fr; const float bb = bi[m];
#pragma unroll
                for (int p = 0; p < 2; ++p) { const u32x4 uv = ureg[m][p]; const f32x4 a0 = acc[m][2 * p], a1 = acc[m][2 * p + 1];
                    u32x4 w;
                    w.x = pk2(bf_lo(uv.x) * (a0[0] + bb), bf_hi(uv.x) * (a0[1] + bb)); w.y = pk2(bf_lo(uv.y) * (a0[2] + bb), bf_hi(uv.y) * (a0[3] + bb));
                    w.z = pk2(bf_lo(uv.z) * (a1[0] + bb), bf_hi(uv.z) * (a1[1] + bb)); w.w = pk2(bf_lo(uv.w) * (a1[2] + bb), bf_hi(uv.w) * (a1[3] + bb));
                    *(u32x4*)(dst + (((size_t)(tok0 + i) * RP + g * GDIM + 64 * wc + 32 * p + 8 * fq) & dmask)) = w; } }
            __syncthreads();
        }
    }
}

__device__ __forceinline__ void attn_phase(LAS unsigned char* lds, const bf16* Q, const bf16* Kb, const bf16* VT, bf16* O, const float* bias2, const float* sinks) {
    const int tid = opaque_tid(), wid = tid >> 6, lane = tid & 63, fr = lane & 15, fq = lane >> 4;
    LAS unsigned char* Ks = lds;
    LAS unsigned char* Vs = lds + 36864;
    LAS float* Bt = (LAS float*)(lds + 36864 + 33792);
    const int NU = BATCH * (SEQ / 128) * NKV, G = gridDim.x;
#define ATT_MAP(u_) ((G != 256) ? (u_) : ((((u_) & 255) & 7) * 128 + (((u_) & 255) >> 3) + 32 * (3 - ((u_) >> 8))))
    u32x4 kreg[4], vreg[4]; bf16x8 qreg[4][2]; float breg = 0.f, breg1 = 0.f;
#define ATT_ISSUE(unit_) do { const int kh_ = (unit_) & 3, nb_ = ((unit_) >> 2) & 31, b_ = (unit_) >> 7, tok0_ = b_ * SEQ + nb_ * 128, kt0_ = tok0_ - 128; \
        _Pragma("unroll") for (int i = 0; i < 4; ++i) { const int q = tid + 512 * i, r = q >> 3, c8 = (q & 7) * 8; u32x4 v = (u32x4){0u, 0u, 0u, 0u}; \
            if (nb_ > 0 || r >= 128) v = *(const u32x4*)(Kb + (size_t)(kt0_ + r) * KVD + kh_ * HD + c8); kreg[i] = v; } \
        _Pragma("unroll") for (int i = 0; i < 4; ++i) { const int q = tid + 512 * i, r = q >> 5, c8 = (q & 31) * 8; u32x4 v = (u32x4){0u, 0u, 0u, 0u}; \
            if (nb_ > 0 || c8 >= 128) v = *(const u32x4*)(VT + (size_t)(kh_ * HD + r) * T + kt0_ + c8); vreg[i] = v; } \
        breg = bias2[kh_ * 640 + tid]; if (tid < 128) breg1 = bias2[kh_ * 640 + 512 + tid]; } while (0)
#define ATT_ISSUE_Q(unit_) do { const int kh_ = (unit_) & 3, nb_ = ((unit_) >> 2) & 31, b_ = (unit_) >> 7, tok0_ = b_ * SEQ + nb_ * 128, hq_ = kh_ * 4 + (wid >> 1); \
          _Pragma("unroll") for (int grp = 0; grp < 4; ++grp) _Pragma("unroll") for (int kk = 0; kk < 2; ++kk) \
              qreg[grp][kk] = *(const bf16x8*)(Q + (size_t)(tok0_ + 64 * (wid & 1) + 16 * grp + fr) * RP + hq_ * HD + kk * 32 + fq * 8); } while (0)
    int unit = blockIdx.x;
    if (unit < NU) { const int cu0 = ATT_MAP(unit); ATT_ISSUE(cu0); ATT_ISSUE_Q(cu0); }
    for (; unit < NU; unit += G) {
        const int cu = ATT_MAP(unit), kh = cu & 3, nb = (cu >> 2) & 31, b = cu >> 7, tok0 = b * SEQ + nb * 128;
#pragma unroll
        for (int i = 0; i < 4; ++i) { const int q = tid + 512 * i, r = q >> 3, c8 = (q & 7) * 8; *(LAS u32x4*)(Ks + r * 144 + c8 * 2) = kreg[i]; }
#pragma unroll
        for (int i = 0; i < 4; ++i) { const int q = tid + 512 * i, r = q >> 5, c8 = (q & 31) * 8; *(LAS u32x4*)(Vs + r * 528 + c8 * 2) = vreg[i]; }
        Bt[tid] = breg; if (tid < 128) Bt[512 + tid] = breg1;
        __syncthreads();
        if (unit + G < NU) { const int cun = ATT_MAP(unit + G); ATT_ISSUE(cun); }
        const int hq = kh * 4 + (wid >> 1); const float sink2 = sinks[hq] * LOG2E;
        const LAS float* bt = Bt + (wid >> 1) * 160 + (fr - 4 * fq);
#pragma unroll
        for (int pr = 0; pr < 2; ++pr) {
            const int q0 = 64 * (wid & 1) + 32 * pr, tl = q0 >> 4;
            f32x4 SA[9], SB[9];
#define ATT_QK2(J0, J1) do { bf16x8 xk[(J1) - (J0)][2]; \
                _Pragma("unroll") for (int j = (J0); j < (J1); ++j) _Pragma("unroll") for (int kk = 0; kk < 2; ++kk) xk[j - (J0)][kk] = *(const LAS bf16x8*)(Ks + (16 * (tl + j) + fr) * 144 + kk * 64 + fq * 16); \
                __builtin_amdgcn_sched_barrier(0); \
                _Pragma("unroll") for (int kk = 0; kk < 2; ++kk) _Pragma("unroll") for (int j = (J0); j < (J1); ++j) { \
                    if (j <= 8) SA[j <= 8 ? j : 0] = __builtin_amdgcn_mfma_f32_16x16x32_bf16(xk[j - (J0)][kk], qreg[2 * pr][kk], kk == 0 ? (f32x4){0.f, 0.f, 0.f, 0.f} : SA[j <= 8 ? j : 0], 0, 0, 0); \
                    if (j >= 1) SB[j >= 1 ? j - 1 : 0] = __builtin_amdgcn_mfma_f32_16x16x32_bf16(xk[j - (J0)][kk], qreg[2 * pr + 1][kk], kk == 0 ? (f32x4){0.f, 0.f, 0.f, 0.f} : SB[j >= 1 ? j - 1 : 0], 0, 0, 0); } \
                __builtin_amdgcn_sched_barrier(0); } while (0)
            ATT_QK2(0, 3); ATT_QK2(3, 6); ATT_QK2(6, 8); ATT_QK2(8, 10);
#undef ATT_QK2
            float mxA = sink2, mxB = sink2;
#pragma unroll
            for (int t = 0; t < 9; ++t)
#pragma unroll
                for (int e = 0; e < 4; ++e) { const float bb = bt[144 - 16 * t - e]; const float la = SA[t][e] + bb, lb = SB[t][e] + bb; SA[t][e] = la; SB[t][e] = lb; mxA = fmaxf(mxA, la); mxB = fmaxf(mxB, lb); }
            mxA = fmaxf(mxA, __shfl_xor(mxA, 16)); mxB = fmaxf(mxB, __shfl_xor(mxB, 16)); mxA = fmaxf(mxA, __shfl_xor(mxA, 32)); mxB = fmaxf(mxB, __shfl_xor(mxB, 32));
            const int tinvA = (nb == 0) ? 8 - tl : 0, tinvB = (nb == 0) ? 7 - tl : 0;
            float lA = 0.f, lB = 0.f;
#pragma unroll
            for (int t = 0; t < 9; ++t) {
                if (t < tinvA) SA[t] = (f32x4){0.f, 0.f, 0.f, 0.f};
                else {
#pragma unroll
                    for (int e = 0; e < 4; ++e) { const float p = __builtin_amdgcn_exp2f(SA[t][e] - mxA); SA[t][e] = p; lA += p; } }
                if (t < tinvB) SB[t] = (f32x4){0.f, 0.f, 0.f, 0.f};
                else {
#pragma unroll
                    for (int e = 0; e < 4; ++e) { const float p = __builtin_amdgcn_exp2f(SB[t][e] - mxB); SB[t][e] = p; lB += p; } } }
            lA += __shfl_xor(lA, 16); lB += __shfl_xor(lB, 16); lA += __shfl_xor(lA, 32); lB += __shfl_xor(lB, 32);
            lA += __builtin_amdgcn_exp2f(sink2 - mxA); lB += __builtin_amdgcn_exp2f(sink2 - mxB);
            bf16x8 ypA[5], ypB[5];
#pragma unroll
            for (int pp = 0; pp < 5; ++pp) { const f32x4 z = (f32x4){0.f, 0.f, 0.f, 0.f};
                const f32x4 loA = SA[2 * pp], hiA = (2 * pp + 1 <= 8) ? SA[(2 * pp + 1 <= 8) ? 2 * pp + 1 : 0] : z;
                const f32x4 loB = (2 * pp >= 1) ? SB[(2 * pp >= 1) ? 2 * pp - 1 : 0] : z, hiB = SB[2 * pp];
                u32x4 w; w.x = pk2(loA[0], loA[1]); w.y = pk2(loA[2], loA[3]); w.z = pk2(hiA[0], hiA[1]); w.w = pk2(hiA[2], hiA[3]); ypA[pp] = __builtin_bit_cast(bf16x8, w);
                w.x = pk2(loB[0], loB[1]); w.y = pk2(loB[2], loB[3]); w.z = pk2(hiB[0], hiB[1]); w.w = pk2(hiB[2], hiB[3]); ypB[pp] = __builtin_bit_cast(bf16x8, w); }
            f32x4 OaA[4], OaB[4];
#define ATT_PV2(D0) do { s16x4 va[5], vb[5]; \
                _Pragma("unroll") for (int pp = 0; pp < 5; ++pp) { \
                    va[pp] = *(const LAS s16x4*)(Vs + (16 * (D0) + fr) * 528 + (16 * (tl + 2 * pp) + 4 * fq) * 2); vb[pp] = *(const LAS s16x4*)(Vs + (16 * (D0) + fr) * 528 + (16 * (tl + 2 * pp + 1) + 4 * fq) * 2); } \
                __builtin_amdgcn_sched_barrier(0); \
                OaA[(D0)] = (f32x4){0.f, 0.f, 0.f, 0.f}; OaB[(D0)] = (f32x4){0.f, 0.f, 0.f, 0.f}; \
                _Pragma("unroll") for (int pp = 0; pp < 5; ++pp) { \
                    const bf16x8 xv = (bf16x8){va[pp][0], va[pp][1], va[pp][2], va[pp][3], vb[pp][0], vb[pp][1], vb[pp][2], vb[pp][3]}; \
                    OaA[(D0)] = __builtin_amdgcn_mfma_f32_16x16x32_bf16(xv, ypA[pp], OaA[(D0)], 0, 0, 0); \
                    OaB[(D0)] = __builtin_amdgcn_mfma_f32_16x16x32_bf16(xv, ypB[pp], OaB[(D0)], 0, 0, 0); } \
                __builtin_amdgcn_sched_barrier(0); } while (0)
            ATT_PV2(0); ATT_PV2(1); ATT_PV2(2); ATT_PV2(3);
#undef ATT_PV2
            const float invA = 1.0f / lA, invB = 1.0f / lB;
            bf16* opA = O + (size_t)(tok0 + q0 + fr) * RP + hq * HD + 4 * fq; bf16* opB = opA + (size_t)16 * RP;
#pragma unroll
            for (int dt = 0; dt < 4; ++dt) { u32x2 w; w.x = pk2(OaA[dt][0] * invA, OaA[dt][1] * invA); w.y = pk2(OaA[dt][2] * invA, OaA[dt][3] * invA); *(u32x2*)(opA + 16 * dt) = w;
                w.x = pk2(OaB[dt][0] * invB, OaB[dt][1] * invB); w.y = pk2(OaB[dt][2] * invB, OaB[dt][3] * invB); *(u32x2*)(opB + 16 * dt) = w; }
        }
        if (unit + G < NU) { const int cun = ATT_MAP(unit + G); ATT_ISSUE_Q(cun); }
        __syncthreads();
    }
#undef ATT_ISSUE_Q
#undef ATT_MAP
#undef ATT_ISSUE
}

__device__ __forceinline__ void final_norm(float* out, const bf16* hbf, const float* ssq, const float* g) {
    const int tid = opaque_tid(), lane = tid & 63, wave = tid >> 6;
    const int gw = blockIdx.x * 8 + wave, NGW = gridDim.x * 8;
    f32x4 gv[4];
#pragma unroll
    for (int j = 0; j < 4; ++j) gv[j] = ((const f32x4*)g)[lane + 64 * j];
#define FN_ROW(L_) ((gridDim.x != 256) ? (L_) : ((((L_) & 2047) >> 3) & 7) * 4096 + (((((L_) & 2047) >> 3) >> 3) * 8 + ((L_) & 7)) + 256 * ((L_) >> 11))
    for (int m0 = gw; m0 < T; m0 += 4 * NGW) {
        u32x2 hv[4][4]; float sp[4];
#pragma unroll
        for (int r = 0; r < 4; ++r) { const int m = FN_ROW(m0 + r * NGW); if (m < T) { sp[r] = ssq[(size_t)m * 16 + (lane & 15)];
#pragma unroll
                for (int j = 0; j < 4; ++j) hv[r][j] = ((const u32x2*)(hbf + (size_t)m * D))[lane + 64 * j]; } }
#pragma unroll
        for (int r = 0; r < 4; ++r) { const int m = FN_ROW(m0 + r * NGW); if (m < T) { float s = sp[r];
                s += __shfl_xor(s, 1); s += __shfl_xor(s, 2); s += __shfl_xor(s, 4); s += __shfl_xor(s, 8);
                const float rr = __builtin_amdgcn_rsqf(s * (1.0f / 1024.0f) + EPS);
                f32x4* xr = (f32x4*)(out + (size_t)m * D) + lane;
#pragma unroll
                for (int j = 0; j < 4; ++j) { f32x4 v = (f32x4){bf_lo(hv[r][j].x), bf_hi(hv[r][j].x), bf_lo(hv[r][j].y), bf_hi(hv[r][j].y)}; v = v * rr * gv[j]; xr[64 * j] = v; } } }
    }
}

#define XB_TMO      128
#define XB_XCNT(j)  (256  + 64 * (j))
#define XB_XSUB(j)  (1280 + 64 * (j))
#define XB_XGEN(j)  (2304 + 64 * (j))
#define XB_TOP      3328
#define XB_TOPGEN   3392
#define XCD_BAR_WORDS 3456
#define XB_SPIN_CAP (1u << 18)

__device__ __forceinline__ unsigned xb_ld(unsigned* p)              { return __hip_atomic_load(p, __ATOMIC_RELAXED, __HIP_MEMORY_SCOPE_AGENT); }
__device__ __forceinline__ unsigned xb_add(unsigned* p, unsigned v) { return __hip_atomic_fetch_add(p, v, __ATOMIC_RELAXED, __HIP_MEMORY_SCOPE_AGENT); }
__device__ __forceinline__ unsigned xb_xcc_id() { return (unsigned)__builtin_amdgcn_s_getreg((3 << 11) | 20) & 0xFu; }
#define XB_SPIN(cond, bar) do { unsigned _sp = 0; while (cond) { __builtin_amdgcn_s_sleep(1); \
    if ((++_sp & 255u) == 0u) { if (xb_ld(&(bar)[XB_TMO])) break; if (_sp > XB_SPIN_CAP) { atomicAdd(&(bar)[XB_TMO], 1u); break; } } } } while (0)

struct XcdBarrier {
    unsigned* bar; unsigned x;
    volatile LAS unsigned* st;
};

__device__ __forceinline__ XcdBarrier xcd_barrier_post(unsigned* bar, volatile LAS unsigned* st) {
    XcdBarrier b; b.bar = bar; b.x = xb_xcc_id(); b.st = st;
    if (threadIdx.x == 0) (void)xb_add(&bar[XB_XCNT(b.x)], 1u);
    return b;
}
__device__ __forceinline__ void xcd_barrier_complete(unsigned* bar, unsigned x, unsigned& nloc, unsigned& nx) {
    const unsigned G = gridDim.x * gridDim.y * gridDim.z;
    unsigned sum, cnt, mine, sp = 0u;
    for (;;) {
        sum = 0u; cnt = 0u; mine = 0u;
#pragma unroll
        for (unsigned j = 0; j < 16; ++j) { const unsigned c = xb_ld(&bar[XB_XCNT(j)]); sum += c; cnt += (c > 0u) ? 1u : 0u; mine = (j == x) ? c : mine; }
        if (sum == G) break;
        __builtin_amdgcn_s_sleep(1);
        if ((++sp & 255u) == 0u) { if (xb_ld(&bar[XB_TMO])) break; if (sp > XB_SPIN_CAP) { atomicAdd(&bar[XB_TMO], 1u); break; } }
    }
    nloc = mine > 0u ? mine : 1u; nx = cnt > 0u ? cnt : 1u;
}

__device__ __forceinline__ void xcd_barrier(const XcdBarrier& b) {
    asm volatile("s_waitcnt vmcnt(0)" ::: "memory");
    __syncthreads();
    if (threadIdx.x == 0) {
        unsigned* bar = b.bar;
        __builtin_amdgcn_s_waitcnt(0);
        unsigned nloc = b.st[0], nx = b.st[1];
        if (nloc == 0u) { xcd_barrier_complete(bar, b.x, nloc, nx); b.st[0] = nloc; b.st[1] = nx; }
        const unsigned old = xb_add(&bar[XB_XSUB(b.x)], 1u);
        const unsigned gen = old / nloc;
        if (old + 1u == (gen + 1u) * nloc) {
            __builtin_amdgcn_fence(__ATOMIC_RELEASE, "agent");
            asm volatile("s_waitcnt vmcnt(0)" ::: "memory");
            const unsigned og = xb_add(&bar[XB_TOP], 1u);
            const unsigned tg = og / nx;
            if (og + 1u == (tg + 1u) * nx) xb_add(&bar[XB_TOPGEN], 1u);
            else XB_SPIN(xb_ld(&bar[XB_TOPGEN]) == tg, bar);
            __builtin_amdgcn_fence(__ATOMIC_ACQUIRE, "agent");
            xb_add(&bar[XB_XGEN(b.x)], 1u);
            asm volatile("s_waitcnt vmcnt(0)" ::: "memory");
        } else {
            XB_SPIN(xb_ld(&bar[XB_XGEN(b.x)]) == gen, bar);
            __builtin_amdgcn_fence(__ATOMIC_ACQUIRE, "agent");
            asm volatile("s_waitcnt vmcnt(0)" ::: "memory");
        }
    }
    __syncthreads();
}


#define XB_LSUB(j)  (3456 + 64 * (j))
#define XB_LGEN(j)  (4480 + 64 * (j))
#define XB_CLSHI(k) (5632 + 64 * (k))
#define XB_CLSLO(k) (6144 + 64 * (k))
__device__ __forceinline__ void xcd_local_barrier(const XcdBarrier& b, unsigned nloc) {
    asm volatile("s_waitcnt vmcnt(0)" ::: "memory");
    __syncthreads();
    if (threadIdx.x == 0) {
        unsigned* bar = b.bar;
        __builtin_amdgcn_s_waitcnt(0);
        const unsigned old = xb_add(&bar[XB_LSUB(b.x)], 1u);
        const unsigned gen = old / nloc;
        if (old + 1u == (gen + 1u) * nloc) xb_add(&bar[XB_LGEN(b.x)], 1u);
        else XB_SPIN(xb_ld(&bar[XB_LGEN(b.x)]) == gen, bar);
        __builtin_amdgcn_fence(__ATOMIC_ACQUIRE, "agent");
        asm volatile("s_waitcnt vmcnt(0)" ::: "memory");
    }
    __syncthreads();
}
#ifndef STAGGER_MODE
#define STAGGER_MODE 0
#endif
#ifndef STAGGER_TICKS
#define STAGGER_TICKS 300
#endif
__device__ __forceinline__ void stagger_delay(int k) {
    if (k > 0) { const unsigned long long t0 = __builtin_amdgcn_s_memrealtime(); const unsigned long long want = (unsigned long long)k * STAGGER_TICKS;
        while (__builtin_amdgcn_s_memrealtime() - t0 < want) __builtin_amdgcn_s_sleep(8); }
}
#ifndef PROBE_U2
#define PROBE_U2 0
#endif
#ifndef PROBE_V2
#define PROBE_V2 0
#endif
#ifndef PROBE_Q2
#define PROBE_Q2 0
#endif
#ifndef PROBE_SYNC2
#define PROBE_SYNC2 0
#endif
#ifndef PROBE_ATT2
#define PROBE_ATT2 0
#endif
#ifndef PROBE_SGU2
#define PROBE_SGU2 0
#endif
#ifndef PROBE_PRO2
#define PROBE_PRO2 0
#endif
#ifndef PROBE_FFN2X
#define PROBE_FFN2X 0
#endif
#define GSYNC() do { if (fast) xcd_local_barrier(bar, 32u); else xcd_barrier(bar); if (PROBE_SYNC2) { if (fast) xcd_local_barrier(bar, 32u); else xcd_barrier(bar); } } while (0)
#ifndef PHASE_MASK
#define PHASE_MASK 0xFFFF
#endif
#define PH(b) if constexpr ((PHASE_MASK >> (b)) & 1)
__global__ void __launch_bounds__(NTHREADS, 2) fwd_megakernel(Args a) {
    extern __shared__ __attribute__((aligned(16))) unsigned char lds_raw[];
    LAS unsigned char* lds = (LAS unsigned char*)lds_raw;
    cg::grid_group grid = cg::this_grid();
    unsigned char* ws = a.ws;
    const int G = gridDim.x, c = blockIdx.x;
    bf16* hbf = (bf16*)(ws + WS_HBF); float* ssq = (float*)(ws + WS_SSQ); float* vsum = (float*)(ws + WS_VSUM); float* vsq = (float*)(ws + WS_VSQ);
    bf16* R1 = (bf16*)(ws + WS_R1);
    LAS float* TAB = (LAS float*)(lds + 131072 + 256);

    volatile LAS unsigned* MISC = (volatile LAS unsigned*)(lds + 131072);
    if (threadIdx.x < 16) MISC[threadIdx.x] = 0u;
    __syncthreads();
    XcdBarrier bar = xcd_barrier_post((unsigned*)(ws + WS_CTL), MISC + 8);
    if (threadIdx.x == 0) {
        __hip_atomic_fetch_max(&bar.bar[XB_CLSHI(blockIdx.x & 7u)], bar.x + 1u, __ATOMIC_RELAXED, __HIP_MEMORY_SCOPE_AGENT);
        __hip_atomic_fetch_max(&bar.bar[XB_CLSLO(blockIdx.x & 7u)], 16u - bar.x, __ATOMIC_RELAXED, __HIP_MEMORY_SCOPE_AGENT); }
    PH(0) prologue(a, lds);
    if (PROBE_PRO2) prologue(a, lds);
    grid.sync();
    bool fast = (G == 256);
#pragma unroll
    for (unsigned k = 0; k < 8; ++k) { const unsigned hi = xb_ld(&bar.bar[XB_CLSHI(k)]), lo = xb_ld(&bar.bar[XB_CLSLO(k)]); fast = fast && (hi >= 1u) && (hi - 1u == 16u - lo); }
#pragma unroll
    for (unsigned j = 0; j < 16; ++j) { const unsigned cx = xb_ld(&bar.bar[XB_XCNT(j)]); fast = fast && (cx == 0u || cx == 32u); }
    fast = __builtin_amdgcn_readfirstlane(fast ? 1 : 0) != 0;
#if defined(PROBE_FORCE_FAST)
    fast = true;
#endif

    for (int layer = 0; layer < 4; ++layer) {
        const bf16* mixA; const bf16* mixW; int mixK;
        if (layer < 2) {
            const bf16* Win = (const bf16*)(ws + WS_WIN) + (size_t)layer * 4096 * D;
            bf16* U = R1; bf16* VTt = R1 + AW;
            PH(1) {
                pg8::Gemm g{hbf, Win, T, 2 * AW, D, D}; pg8::StaticOrder S; S.init(T, 2 * AW, G, c);
                pg8::EpiRowAct<1, 0, true> E{U, RP, ssq, 1.0f, VTt, AW, vsum, vsq, TAB};
                if (PROBE_U2) pg8::gemm_phase<pg8::EpiRowAct<1, 0, true>, pg8::StaticOrder, true, true>(lds, g, S, E);
                pg8::gemm_phase<pg8::EpiRowAct<1, 0, true>, pg8::StaticOrder, true, true>(lds, g, S, E);
            }
            GSYNC();
            PH(3) sgu_phase(lds, (const bf16*)(ws + WS_WC) + (size_t)layer * NGRP * CHUNK * CHUNK, a.a_ln_g + (size_t)layer * AW, a.a_b_s + (size_t)layer * NGRP * CHUNK, VTt, U, vsum, vsq, U, ~(size_t)0);
            GSYNC();
            mixA = U; mixW = (const bf16*)(ws + WS_WOUT) + (size_t)layer * D * AW; mixK = AW;
        } else {
            const int j = layer - 2;
            bf16* Qb = R1; bf16* Ob = R1 + D;
            bf16* Kb = (bf16*)(ws + WS_K); bf16* VTb = (bf16*)(ws + WS_VT);
            PH(4) {
                pg8::Gemm g{hbf, (const bf16*)(ws + WS_WQ) + (size_t)j * D * D, T, D, D, D}; pg8::StaticOrder S; S.init(T, D, G, c);
                pg8::EpiRowAct<0> E{Qb, RP, ssq, QSCALE, nullptr, 0, nullptr, nullptr, TAB};
                pg8::gemm_phase<pg8::EpiRowAct<0>, pg8::StaticOrder, true, true>(lds, g, S, E);
            }
            if (layer == 2) {
                PH(5) {
                    pg8::Gemm g{hbf, (const bf16*)(ws + WS_WKV), T, KVD, D, D}; pg8::StaticOrder S; S.init(T, KVD, G, c);
                    pg8::EpiRowAct<0> E{Kb, KVD, ssq, 1.0f, nullptr, 0, nullptr, nullptr, TAB};
                    pg8::gemm_phase<pg8::EpiRowAct<0>, pg8::StaticOrder, true, true>(lds, g, S, E);
                }
                PH(6) {
                    pg8::Gemm g{(const bf16*)(ws + WS_WKV) + (size_t)D * KVD, hbf, KVD, T, D, D}; pg8::StaticOrder S; S.init(KVD, T, G, (c + G / 2) % G);
                    pg8::EpiColAct<0, false> E{VTb, T, ssq, nullptr, nullptr};
                    pg8::gemm_phase<pg8::EpiColAct<0, false>, pg8::StaticOrder, true, true>(lds, g, S, E);
                }
            }
            GSYNC();
            if (PROBE_ATT2) attn_phase(lds, Qb, Kb, VTb, Ob, (const float*)(ws + WS_BIAS), a.b_sinks + j * NH);
            PH(7) attn_phase(lds, Qb, Kb, VTb, Ob, (const float*)(ws + WS_BIAS), a.b_sinks + j * NH);
            GSYNC();
            mixA = Ob; mixW = (const bf16*)(ws + WS_WO) + (size_t)j * D * D; mixK = D;
        }
        PH(8) {
            pg8::Gemm g{mixA, mixW, T, D, mixK, RP}; pg8::StaticOrder S; S.init(T, D, G, c);
            pg8::EpiResid E{hbf, ssq, nullptr};
            pg8::gemm_phase<pg8::EpiResid, pg8::StaticOrder, true, true>(lds, g, S, E);
        }
        GSYNC();
        bf16* Fb = R1;
        PH(9) {
            pg8::Gemm g{hbf, (const bf16*)(ws + WS_W1) + (size_t)layer * D * FF, T, FF, D, D}; pg8::StaticOrder S; S.init(T, FF, G, c);
            pg8::EpiRowAct<2> E{Fb, FF, ssq, 1.0f, nullptr, 0, nullptr, nullptr, TAB};
            if (STAGGER_MODE == 1) stagger_delay(c & 7); else if (STAGGER_MODE == 2) stagger_delay((c >> 3) & 7);
            if (PROBE_FFN2X == 1) pg8::gemm_phase<pg8::EpiRowAct<2>, pg8::StaticOrder, true, true>(lds, g, S, E);
            if (PROBE_FFN2X == 3) { pg8::EpiRowAct<2, 1> E1{Fb, FF, ssq, 1.0f, nullptr, 0, nullptr, nullptr, TAB}; pg8::gemm_phase<pg8::EpiRowAct<2, 1>, pg8::StaticOrder, true, true>(lds, g, S, E1); }
            if (PROBE_FFN2X == 4) { pg8::EpiRowAct<2, 2> E2{Fb, FF, ssq, 1.0f, nullptr, 0, nullptr, nullptr, TAB}; pg8::gemm_phase<pg8::EpiRowAct<2, 2>, pg8::StaticOrder, true, true>(lds, g, S, E2); }
            if (PROBE_FFN2X == 2) { pg8::EpiNull EN{}; pg8::gemm_phase<pg8::EpiNull, pg8::StaticOrder, true, true>(lds, g, S, EN); }
            pg8::gemm_phase<pg8::EpiRowAct<2>, pg8::StaticOrder, true, true>(lds, g, S, E);
        }
        GSYNC();
        PH(10) {
            pg8::Gemm g{Fb, (const bf16*)(ws + WS_W2) + (size_t)layer * D * FF, T, D, FF, FF}; pg8::StaticOrder S; S.init(T, D, G, c);
            pg8::EpiResid E{hbf, ssq, nullptr};
            pg8::gemm_phase<pg8::EpiResid, pg8::StaticOrder, true, true>(lds, g, S, E);
        }
        GSYNC();
    }
    PH(11) final_norm(a.out, hbf, ssq, a.final_g);
}

extern "C" void kernel_launch(void* const* d_in, const int* in_sizes, int n_in, void* d_out, int out_size, void* d_ws, size_t ws_size, hipStream_t stream) {
    static int grid = 0;
    if (grid == 0) {
        if (n_in != 18 || in_sizes[0] != T * D || out_size != T * D || ws_size < WS_END) { fprintf(stderr, "kernel_launch: unexpected shapes (n_in %d in0 %d out %d ws %zu)\n", n_in, n_in > 0 ? in_sizes[0] : -1, out_size, ws_size); grid = -1; return; }
        int dev = 0, cus = 0, per_cu = 0;
        hipGetDevice(&dev); hipDeviceGetAttribute(&cus, hipDeviceAttributeMultiprocessorCount, dev);
        if (hipFuncSetAttribute((const void*)fwd_megakernel, hipFuncAttributeMaxDynamicSharedMemorySize, LDS_BYTES) != hipSuccess) { fprintf(stderr, "kernel_launch: hipFuncSetAttribute failed\n"); grid = -1; return; }
        if (hipOccupancyMaxActiveBlocksPerMultiprocessor(&per_cu, (const void*)fwd_megakernel, NTHREADS, LDS_BYTES) != hipSuccess || per_cu < 1) { fprintf(stderr, "kernel_launch: occupancy query says %d\n", per_cu); per_cu = 1; }
        (void)hipGetLastError();
        grid = cus * 1;
    }
    if (grid < 0) return;
    if (hipMemsetAsync((char*)d_ws + WS_CTL, 0, CTL_ZERO_BYTES, stream) != hipSuccess) { fprintf(stderr, "kernel_launch: memset failed\n"); return; }
    Args a{};
    a.x = (const float*)d_in[0]; a.mix_g = (const float*)d_in[1]; a.ffn_g = (const float*)d_in[2]; a.a_w_in = (const float*)d_in[3]; a.a_ln_g = (const float*)d_in[4];
    a.a_w_s = (const float*)d_in[5]; a.a_b_s = (const float*)d_in[6]; a.a_w_out = (const float*)d_in[7]; a.kv_g = (const float*)d_in[8]; a.w_k = (const float*)d_in[9];
    a.w_v = (const float*)d_in[10]; a.b_w_q = (const float*)d_in[11]; a.b_sinks = (const float*)d_in[12]; a.b_w_o = (const float*)d_in[13]; a.rel_bias = (const float*)d_in[14];
    a.ffn_w1 = (const float*)d_in[15]; a.ffn_w2 = (const float*)d_in[16]; a.final_g = (const float*)d_in[17];
    a.out = (float*)d_out; a.ws = (unsigned char*)d_ws;
    void* args[] = {&a};
    hipError_t e = hipLaunchCooperativeKernel((const void*)fwd_megakernel, dim3(grid), dim3(NTHREADS), args, LDS_BYTES, stream);
    if (e != hipSuccess) fprintf(stderr, "kernel_launch: cooperative launch failed: %s (grid %d)\n", hipGetErrorString(e), grid);
}
```

```cpp
#include <hip/hip_runtime.h>
#include <hip/hip_cooperative_groups.h>
#include <cstdio>
#include <cstdint>
namespace cg = cooperative_groups;
__device__ __forceinline__ int opaque_tid() { int t = threadIdx.x; asm volatile("" : "+v"(t)); return t; }

namespace pg8 {
#define PG8_LAS __attribute__((address_space(3)))
typedef unsigned short bf16_t;
typedef short bf16x8 __attribute__((ext_vector_type(8)));
typedef float f32x4 __attribute__((ext_vector_type(4)));
typedef unsigned u32x4 __attribute__((ext_vector_type(4)));
constexpr int BM = 256, BK = 64, HALF = 128, HTB = HALF * BK * 2  , STAGE_BYTES = 8 * HTB, NXCD = 8, WGM = 8;

__host__ __device__ __forceinline__ int lds_byte(int r, int c) { const int st = (r >> 4) * 2 + (c >> 5), rr = r & 15, cc = c & 31, ob = rr * 64 + cc * 2; return st * 1024 + (ob ^ (((ob >> 9) & 1) << 5)); }
__host__ __device__ __forceinline__ void stage_rc(int b, int& R, int& C) { const int st = b / 1024, sb = b % 1024, swz = sb ^ (((sb >> 9) & 1) << 5); R = (st >> 1) * 16 + swz / 64; C = (st & 1) * 32 + (swz % 64) / 2; }
__host__ __device__ __forceinline__ int perm32(int rho) { const int n = rho >> 4, i = rho & 15; return 8 * (i >> 2) + 4 * n + (i & 3); }

struct Unit { int pm, pn; };
struct Gemm { const bf16_t* A; const bf16_t* Bt; int M, N, K; int lda; };

struct StaticOrder {
    int nM, nN, nwg, G, c;
    __host__ __device__ void init(int M, int N, int G_, int c_) { nM = M / BM; nN = N / BM; nwg = nM * nN; G = G_; c = c_; }
    __host__ __device__ bool next(int i, Unit& u) const {
        const long L = (long)i * G + c; if (L >= nwg) return false;
        int wgid = (int)L; { const int q = nwg / NXCD, r = nwg % NXCD, xcd = wgid % NXCD, off = wgid / NXCD; wgid = (xcd < r ? xcd * (q + 1) : r * (q + 1) + (xcd - r) * q) + off; }
        const int nig = WGM * nN, gid = wgid / nig, fm = gid * WGM, gsz = (nM - fm) < WGM ? (nM - fm) : WGM;
        u.pm = fm + ((wgid % nig) % gsz); u.pn = (wgid % nig) / gsz; return true;
    }
    __device__ __forceinline__ void a_ready(const Unit&) const {}
    __device__ __forceinline__ void done(const Unit&) const {}
};
__device__ __forceinline__ unsigned cvt_pk_bf16(float lo, float hi) { unsigned r; asm volatile("v_cvt_pk_bf16_f32 %0, %1, %2" : "=v"(r) : "v"(lo), "v"(hi)); return r; }
typedef float f32x2 __attribute__((ext_vector_type(2)));
__device__ __forceinline__ f32x2 gelu_pk(f32x2 v) {
    const f32x2 av = __builtin_elementwise_abs(v);
    f32x2 p = av * (-4.88118711e-04f) + 7.19881016e-03f; p = p * av + (-5.21468014e-02f); p = p * av + (-4.59595724e-01f); p = p * av + (-1.15100057e+00f); p = p * av + (-1.0f);
    f32x2 e; e.x = __builtin_amdgcn_exp2f(p.x); e.y = __builtin_amdgcn_exp2f(p.y);
    f32x2 r; r.x = __builtin_fmaxf(v.x, 0.f); r.y = __builtin_fmaxf(v.y, 0.f);
    return r - av * e;
}
template <class Epi, class Sched, bool ALIGN_EPI = false, bool SP2 = false>
__device__ __forceinline__ void gemm_phase(PG8_LAS unsigned char* lds, const Gemm g, const Sched& S, const Epi& E) {
    const int tid = opaque_tid(), wid = __builtin_amdgcn_readfirstlane(tid >> 6), lane = tid & 63, wr = wid >> 2, wc = wid & 3, fr = lane & 15, fq = lane >> 4;
    const int K = g.K, nt = K / BK;
    unsigned voffA[2], voffB[2];
#pragma unroll
    for (int i = 0; i < 2; ++i) { int R, C; stage_rc(tid * 16 + i * 8192, R, C); const int Rb = Epi::PERM ? ((R & ~31) + perm32(R & 31)) : R;
        voffA[i] = (unsigned)(R * g.lda + C) * 2u; voffB[i] = (unsigned)(Rb * K + C) * 2u; }
    const size_t kstep = (size_t)(BK * 2);
    const size_t hstepA = (size_t)HALF * g.lda * 2, hstepB = (size_t)HALF * K * 2;
    const size_t tstepA = 2 * hstepA, tstepB = 2 * hstepB;
    const unsigned ldsw = (unsigned)wid * 1024u;
    const int aoff = lds_byte(wr * 64 + fr, fq * 8), boff = lds_byte(wc * 32 + fr, fq * 8);
#define PG8_SA(b, h) (((b) * 2 + (h)) * HTB)
#define PG8_SB(b, h) ((4 + (b) * 2 + (h)) * HTB)
#define PG8_STAGE(bufoff, gbase, voff) do { _Pragma("unroll") for (int _i = 0; _i < 2; ++_i) \
        __builtin_amdgcn_global_load_lds((const unsigned*)((const char*)(gbase) + (voff)[_i]), (PG8_LAS unsigned*)(lds + (bufoff) + ldsw + _i * 8192), 16, 0, 0); } while (0)
#define PG8_LDA(dst, b, h) do { _Pragma("unroll") for (int m = 0; m < 4; ++m) _Pragma("unroll") for (int k = 0; k < 2; ++k) dst[m][k] = *(const PG8_LAS bf16x8*)(lds + PG8_SA(b, h) + aoff + m * 2048 + k * 1024); } while (0)
#define PG8_LDB(dst, b, h) do { _Pragma("unroll") for (int n = 0; n < 2; ++n) _Pragma("unroll") for (int k = 0; k < 2; ++k) dst[n][k] = *(const PG8_LAS bf16x8*)(lds + PG8_SB(b, h) + boff + n * 2048 + k * 1024); } while (0)
#define PG8_MMA(ai, bj, At, Bt) do { __builtin_amdgcn_s_setprio(1); _Pragma("unroll") for (int m = 0; m < 4; ++m) _Pragma("unroll") for (int n = 0; n < 2; ++n) _Pragma("unroll") for (int k = 0; k < 2; ++k) \
        acc[ai][bj][m][n] = __builtin_amdgcn_mfma_f32_16x16x32_bf16(Bt[n][k], At[m][k], acc[ai][bj][m][n], 0, 0, 0); __builtin_amdgcn_s_setprio(0); } while (0)
#define PG8_WAIT_V(n) asm volatile("s_waitcnt vmcnt(" #n ")" ::: "memory")
#define PG8_WAIT_L(n) asm volatile("s_waitcnt lgkmcnt(" #n ")" ::: "memory")
#define PG8_BAR __builtin_amdgcn_s_barrier()
#define PG8_SCHED __builtin_amdgcn_sched_barrier(0)
    Unit cur, nxt; int ui = 0;
    if (!S.next(0, cur)) return;
    f32x4 acc[2][2][4][2];
#pragma unroll
    for (int a = 0; a < 2; ++a)
#pragma unroll
        for (int b = 0; b < 2; ++b)
#pragma unroll
            for (int m = 0; m < 4; ++m)
#pragma unroll
                for (int n = 0; n < 2; ++n) acc[a][b][m][n] = (f32x4){0.f, 0.f, 0.f, 0.f};
    bf16x8 At[4][2], B0[2][2], B1[2][2];
    const char* cA = (const char*)g.A + (size_t)cur.pm * tstepA; const char* cB = (const char*)g.Bt + (size_t)cur.pn * tstepB;
    S.a_ready(cur);
    E.prefetch(cur, wid, lane);
    if constexpr (SP2) {
        PG8_STAGE(PG8_SB(0, 0), cB, voffB); PG8_STAGE(PG8_SB(0, 1), cB + hstepB, voffB); PG8_STAGE(PG8_SA(0, 0), cA, voffA); PG8_STAGE(PG8_SA(0, 1), cA + hstepA, voffA);
        if (wr == 1) PG8_BAR;
        PG8_WAIT_V(2); PG8_BAR;
        PG8_STAGE(PG8_SB(1, 0), cB + kstep, voffB); PG8_STAGE(PG8_SA(1, 0), cA + kstep, voffA); PG8_STAGE(PG8_SB(1, 1), cB + hstepB + kstep, voffB);
        PG8_WAIT_V(6); PG8_BAR;
    } else {
        PG8_STAGE(PG8_SB(0, 0), cB, voffB); PG8_STAGE(PG8_SA(0, 0), cA, voffA); PG8_STAGE(PG8_SB(0, 1), cB + hstepB, voffB); PG8_STAGE(PG8_SA(0, 1), cA + hstepA, voffA);
        if (wr == 1) PG8_BAR;
        PG8_WAIT_V(4); PG8_BAR;
        PG8_STAGE(PG8_SB(1, 0), cB + kstep, voffB); PG8_STAGE(PG8_SA(1, 0), cA + kstep, voffA); PG8_STAGE(PG8_SB(1, 1), cB + hstepB + kstep, voffB);
        PG8_WAIT_V(6); PG8_BAR;
    }
    for (;;) {
        const bool has_next = S.next(ui + 1, nxt);
        const char* nA = has_next ? (const char*)g.A + (size_t)nxt.pm * tstepA : cA; const char* nB = has_next ? (const char*)g.Bt + (size_t)nxt.pn * tstepB : cB;
        for (int t = 0; t < nt; t += 2) {
            const bool last = (t == nt - 2);
            const char* a1 = cA + (size_t)(t + 1) * kstep;
            const char* a2 = last ? nA : cA + (size_t)(t + 2) * kstep; const char* b2 = last ? nB : cB + (size_t)(t + 2) * kstep;
            const char* a3 = a2 + kstep; const char* b3 = b2 + kstep;
            if (last && has_next) S.a_ready(nxt);
            if constexpr (SP2) {
            PG8_LDB(B0, 0, 0); PG8_LDB(B1, 0, 1); PG8_SCHED; PG8_LDA(At, 0, 0); PG8_STAGE(PG8_SA(1, 1), a1 + hstepA, voffA);
            PG8_WAIT_V(8); PG8_WAIT_L(0); PG8_BAR; PG8_MMA(0, 0, At, B0); PG8_MMA(0, 1, At, B1); PG8_BAR; PG8_SCHED;
            PG8_LDA(At, 0, 1); PG8_STAGE(PG8_SB(0, 0), b2, voffB); PG8_STAGE(PG8_SB(0, 1), b2 + hstepB, voffB); PG8_STAGE(PG8_SA(0, 0), a2, voffA);
            PG8_WAIT_V(8); PG8_WAIT_L(0); PG8_BAR; PG8_MMA(1, 0, At, B0); PG8_MMA(1, 1, At, B1); PG8_BAR; PG8_SCHED;
            PG8_LDB(B0, 1, 0); PG8_LDB(B1, 1, 1); PG8_SCHED; PG8_LDA(At, 1, 0); PG8_STAGE(PG8_SA(0, 1), a2 + hstepA, voffA);
            PG8_WAIT_V(8); PG8_WAIT_L(0); PG8_BAR; PG8_MMA(0, 0, At, B0); PG8_MMA(0, 1, At, B1); PG8_BAR; PG8_SCHED;
            PG8_LDA(At, 1, 1); PG8_STAGE(PG8_SB(1, 0), b3, voffB); PG8_STAGE(PG8_SB(1, 1), b3 + hstepB, voffB); PG8_STAGE(PG8_SA(1, 0), a3, voffA);
            PG8_WAIT_V(8); PG8_WAIT_L(0); PG8_BAR; PG8_MMA(1, 0, At, B0); PG8_MMA(1, 1, At, B1); PG8_BAR; PG8_SCHED;
            } else {
            PG8_LDB(B0, 0, 0); PG8_SCHED; PG8_LDA(At, 0, 0); PG8_STAGE(PG8_SA(1, 1), a1 + hstepA, voffA);
            PG8_WAIT_L(8); PG8_BAR; PG8_WAIT_L(0); PG8_MMA(0, 0, At, B0); PG8_BAR; PG8_SCHED;
            PG8_LDB(B1, 0, 1); PG8_STAGE(PG8_SB(0, 0), b2, voffB);
            PG8_BAR; PG8_WAIT_L(0); PG8_MMA(0, 1, At, B1); PG8_BAR;
            PG8_LDA(At, 0, 1); PG8_STAGE(PG8_SA(0, 0), a2, voffA);
            PG8_BAR; PG8_WAIT_L(0); PG8_MMA(1, 0, At, B0); PG8_BAR; PG8_SCHED;
            PG8_STAGE(PG8_SB(0, 1), b2 + hstepB, voffB);
            PG8_WAIT_V(6); PG8_BAR; PG8_MMA(1, 1, At, B1); PG8_BAR;
            PG8_LDB(B0, 1, 0); PG8_SCHED; PG8_LDA(At, 1, 0); PG8_STAGE(PG8_SA(0, 1), a2 + hstepA, voffA);
            PG8_WAIT_L(8); PG8_BAR; PG8_WAIT_L(0); PG8_MMA(0, 0, At, B0); PG8_BAR; PG8_SCHED;
            PG8_LDB(B1, 1, 1); PG8_STAGE(PG8_SB(1, 0), b3, voffB);
            PG8_BAR; PG8_WAIT_L(0); PG8_MMA(0, 1, At, B1); PG8_BAR;
            PG8_LDA(At, 1, 1); PG8_STAGE(PG8_SA(1, 0), a3, voffA);
            PG8_BAR; PG8_WAIT_L(0); PG8_MMA(1, 0, At, B0); PG8_BAR; PG8_SCHED;
            PG8_STAGE(PG8_SB(1, 1), b3 + hstepB, voffB);
            PG8_WAIT_V(6); PG8_BAR; PG8_MMA(1, 1, At, B1); PG8_BAR;
            }
        }
        if constexpr (ALIGN_EPI) { if (wr == 0) PG8_BAR; }
        if constexpr (!Epi::AFTER_DRAIN) { E(acc, cur, wr, wc, fr, fq); S.done(cur); }
        if (!has_next) break;
#pragma unroll
        for (int a = 0; a < 2; ++a)
#pragma unroll
            for (int b = 0; b < 2; ++b)
#pragma unroll
                for (int m = 0; m < 4; ++m)
#pragma unroll
                    for (int n = 0; n < 2; ++n) acc[a][b][m][n] = (f32x4){0.f, 0.f, 0.f, 0.f};
        cur = nxt; cA = nA; cB = nB; ++ui;
        E.prefetch(cur, wid, lane);
        if constexpr (ALIGN_EPI) { if (wr == 1) PG8_BAR; }
    }
    PG8_WAIT_V(0);
    if constexpr (!ALIGN_EPI) { if (wr == 0) PG8_BAR; }
    PG8_BAR;
    if constexpr (Epi::AFTER_DRAIN) { E.fused(acc, cur, wr, wc, fr, fq, lds, wid, lane); S.done(cur); }
#undef PG8_SA
#undef PG8_SB
#undef PG8_STAGE
#undef PG8_LDA
#undef PG8_LDB
#undef PG8_MMA
#undef PG8_WAIT_V
#undef PG8_WAIT_L
#undef PG8_BAR
#undef PG8_SCHED
}
}
constexpr int BATCH = 8, SEQ = 4096, T = BATCH * SEQ, D = 1024, FF = 4096, AW = 2048, NGRP = 8, GDIM = 256, CHUNK = 128;
constexpr int NH = 16, NKV = 4, HD = 64, KVD = NKV * HD;
constexpr float EPS = 1e-6f;
constexpr float LOG2E = 1.4426950408889634f;
constexpr float QSCALE = 0.125f * LOG2E;

namespace pg8 {
typedef short s16x4 __attribute__((ext_vector_type(4)));
__device__ __forceinline__ void ssq_prefetch(PG8_LAS float* tab, const float* ssq, int tile, int wid, int lane) {
#pragma unroll
    for (int i = 0; i < 2; ++i) { const int j = 2 * wid + i;
        const char* g = (const char*)ssq + (size_t)(tile * BM + 16 * j) * 64 + lane * 16;
        __builtin_amdgcn_global_load_lds((const unsigned*)g, (PG8_LAS unsigned*)((PG8_LAS unsigned char*)tab + j * 1024), 16, 0, 0); }
}
__device__ __forceinline__ void row_rstd_lds(float (&rs)[2][4], const PG8_LAS float* tab, int r0, int fq, float mul) {
    f32x4 p[2][4];
#pragma unroll
    for (int ai = 0; ai < 2; ++ai)
#pragma unroll
        for (int m = 0; m < 4; ++m) p[ai][m] = *(const PG8_LAS f32x4*)(tab + (r0 + ai * HALF + m * 16) * 16 + 4 * fq);
    float s[2][4];
#pragma unroll
    for (int ai = 0; ai < 2; ++ai)
#pragma unroll
        for (int m = 0; m < 4; ++m) s[ai][m] = (p[ai][m][0] + p[ai][m][1]) + (p[ai][m][2] + p[ai][m][3]);
#pragma unroll
    for (int ai = 0; ai < 2; ++ai)
#pragma unroll
        for (int m = 0; m < 4; ++m) s[ai][m] += __shfl_xor(s[ai][m], 16);
#pragma unroll
    for (int ai = 0; ai < 2; ++ai)
#pragma unroll
        for (int m = 0; m < 4; ++m) s[ai][m] += __shfl_xor(s[ai][m], 32);
#pragma unroll
    for (int ai = 0; ai < 2; ++ai)
#pragma unroll
        for (int m = 0; m < 4; ++m) rs[ai][m] = mul * __builtin_amdgcn_rsqf(s[ai][m] * (1.0f / 1024.0f) + 1e-6f);
}
__device__ __forceinline__ void row_rstd(float (&rs)[2][4], const float* ssq, int row0, int fq, float mul) {
    f32x4 p[2][4];
#pragma unroll
    for (int ai = 0; ai < 2; ++ai)
#pragma unroll
        for (int m = 0; m < 4; ++m) p[ai][m] = *(const f32x4*)(ssq + (size_t)(row0 + ai * HALF + m * 16) * 16 + 4 * fq);
    __builtin_amdgcn_sched_barrier(0);
    float s[2][4];
#pragma unroll
    for (int ai = 0; ai < 2; ++ai)
#pragma unroll
        for (int m = 0; m < 4; ++m) s[ai][m] = (p[ai][m][0] + p[ai][m][1]) + (p[ai][m][2] + p[ai][m][3]);
#pragma unroll
    for (int ai = 0; ai < 2; ++ai)
#pragma unroll
        for (int m = 0; m < 4; ++m) s[ai][m] += __shfl_xor(s[ai][m], 16);
#pragma unroll
    for (int ai = 0; ai < 2; ++ai)
#pragma unroll
        for (int m = 0; m < 4; ++m) s[ai][m] += __shfl_xor(s[ai][m], 32);
#pragma unroll
    for (int ai = 0; ai < 2; ++ai)
#pragma unroll
        for (int m = 0; m < 4; ++m) rs[ai][m] = mul * __builtin_amdgcn_rsqf(s[ai][m] * (1.0f / 1024.0f) + 1e-6f);
    __builtin_amdgcn_sched_barrier(0);
}
template <int ACT, int MODE = 0, bool STATS = false> struct EpiRowAct {
    static constexpr bool PERM = true, AFTER_DRAIN = false;
    bf16_t* O; int ldc; const float* ssq; float sc; bf16_t* O2; int split; float* vsum; float* vsq; PG8_LAS float* tab;
    __device__ __forceinline__ void prefetch(const Unit& u, int wid, int lane) const { ssq_prefetch(tab, ssq, u.pm, wid, lane); }
    __device__ __forceinline__ void operator()(const f32x4 (&acc)[2][2][4][2], const Unit& u, int wr, int wc, int fr, int fq) const {
        const int row0 = u.pm * BM + wr * 64 + fr; int colt = u.pn * BM; bf16_t* base = O; const bool second = STATS && (colt >= split);
        if (STATS) { if (second) { base = O2; colt -= split; } }
        const int col0 = colt + wc * 32 + 8 * fq;
        float pss[2][4], pqs[2][4];
        float rs[2][4]; if (MODE != 1) { row_rstd_lds(rs, tab, wr * 64 + fr, fq, sc); asm volatile("s_waitcnt lgkmcnt(0)\n\ts_barrier" ::: "memory");   } else {
#pragma unroll
            for (int ai = 0; ai < 2; ++ai)
#pragma unroll
                for (int m = 0; m < 4; ++m) rs[ai][m] = sc; }
#pragma unroll
        for (int ai = 0; ai < 2; ++ai)
#pragma unroll
            for (int m = 0; m < 4; ++m) { const int row = row0 + ai * HALF + m * 16; bf16_t* rowp = base + (size_t)row * ldc + col0; const float r = rs[ai][m]; float ps = 0.f, pq = 0.f;
#pragma unroll
                for (int bj = 0; bj < 2; ++bj) { f32x4 v0 = acc[ai][bj][m][0] * r, v1 = acc[ai][bj][m][1] * r;
                    if (ACT == 1) { f32x2 a = gelu_pk((f32x2){v0[0], v0[1]}), b = gelu_pk((f32x2){v0[2], v0[3]}), c = gelu_pk((f32x2){v1[0], v1[1]}), d = gelu_pk((f32x2){v1[2], v1[3]});
                        v0 = (f32x4){a.x, a.y, b.x, b.y}; v1 = (f32x4){c.x, c.y, d.x, d.y}; }
                    if (ACT == 2) {
#pragma unroll
                        for (int e = 0; e < 4; ++e) { const float a = fmaxf(v0[e], 0.f), b = fmaxf(v1[e], 0.f); v0[e] = a * a; v1[e] = b * b; } }
                    if (STATS) { ps += (v0[0] + v0[1]) + (v0[2] + v0[3]) + (v1[0] + v1[1]) + (v1[2] + v1[3]);
                        pq += (v0[0] * v0[0] + v0[1] * v0[1]) + (v0[2] * v0[2] + v0[3] * v0[3]) + (v1[0] * v1[0] + v1[1] * v1[1]) + (v1[2] * v1[2] + v1[3] * v1[3]); }
                    u32x4 w; w.x = cvt_pk_bf16(v0[0], v0[1]); w.y = cvt_pk_bf16(v0[2], v0[3]); w.z = cvt_pk_bf16(v1[0], v1[1]); w.w = cvt_pk_bf16(v1[2], v1[3]);
                    if (MODE != 2) *(u32x4*)(rowp + bj * HALF) = w; else asm volatile("" :: "v"(w)); }
                if (STATS) { pss[ai][m] = ps; pqs[ai][m] = pq; } }
        if (STATS) { if (second) {
#pragma unroll
            for (int ai = 0; ai < 2; ++ai)
#pragma unroll
                for (int m = 0; m < 4; ++m) { pss[ai][m] += __shfl_xor(pss[ai][m], 16); pqs[ai][m] += __shfl_xor(pqs[ai][m], 16); }
#pragma unroll
            for (int ai = 0; ai < 2; ++ai)
#pragma unroll
                for (int m = 0; m < 4; ++m) { pss[ai][m] += __shfl_xor(pss[ai][m], 32); pqs[ai][m] += __shfl_xor(pqs[ai][m], 32); }
            if (fq == 0) {
#pragma unroll
                for (int ai = 0; ai < 2; ++ai)
#pragma unroll
                    for (int m = 0; m < 4; ++m) { const size_t si = (size_t)(row0 + ai * HALF + m * 16) * 32 + (colt >> 8) * 4 + wc; vsum[si] = pss[ai][m]; vsq[si] = pqs[ai][m]; } } } }
    }
};
template <int ACT, bool STATS> struct EpiColAct {
    static constexpr bool PERM = true, AFTER_DRAIN = false;
    bf16_t* O; int ldc; const float* ssq; float* vsum; float* vsq;
    __device__ __forceinline__ void prefetch(const Unit&, int, int) const {}
    __device__ __forceinline__ void operator()(const f32x4 (&acc)[2][2][4][2], const Unit& u, int wr, int wc, int fr, int fq) const {
        const int row0 = u.pm * BM + wr * 64 + fr, col0 = u.pn * BM + wc * 32 + 8 * fq;
        float cs[2][8];
#pragma unroll
        for (int bj = 0; bj < 2; ++bj)
#pragma unroll
            for (int j = 0; j < 8; ++j) { float s = ssq[(size_t)(col0 + bj * HALF + j) * 16 + fr];
                s += __shfl_xor(s, 1); s += __shfl_xor(s, 2); s += __shfl_xor(s, 4); s += __shfl_xor(s, 8);
                cs[bj][j] = __builtin_amdgcn_rsqf(s * (1.0f / 1024.0f) + 1e-6f); }
        float psum[2][8], psq[2][8];
#pragma unroll
        for (int bj = 0; bj < 2; ++bj)
#pragma unroll
            for (int j = 0; j < 8; ++j) { psum[bj][j] = 0.f; psq[bj][j] = 0.f; }
#pragma unroll
        for (int ai = 0; ai < 2; ++ai)
#pragma unroll
            for (int m = 0; m < 4; ++m) { bf16_t* rowp = O + (size_t)(row0 + ai * HALF + m * 16) * ldc + col0;
#pragma unroll
                for (int bj = 0; bj < 2; ++bj) { f32x4 v0 = acc[ai][bj][m][0], v1 = acc[ai][bj][m][1];
#pragma unroll
                    for (int e = 0; e < 4; ++e) { v0[e] *= cs[bj][e]; v1[e] *= cs[bj][4 + e]; }
                    if (ACT == 1) { f32x2 a = gelu_pk((f32x2){v0[0], v0[1]}), b = gelu_pk((f32x2){v0[2], v0[3]}), c = gelu_pk((f32x2){v1[0], v1[1]}), d = gelu_pk((f32x2){v1[2], v1[3]});
                        v0 = (f32x4){a.x, a.y, b.x, b.y}; v1 = (f32x4){c.x, c.y, d.x, d.y}; }
                    if (STATS) {
#pragma unroll
                        for (int e = 0; e < 4; ++e) { psum[bj][e] += v0[e]; psq[bj][e] += v0[e] * v0[e]; psum[bj][4 + e] += v1[e]; psq[bj][4 + e] += v1[e] * v1[e]; } }
                    u32x4 w; w.x = cvt_pk_bf16(v0[0], v0[1]); w.y = cvt_pk_bf16(v0[2], v0[3]); w.z = cvt_pk_bf16(v1[0], v1[1]); w.w = cvt_pk_bf16(v1[2], v1[3]);
                    *(u32x4*)(rowp + bj * HALF) = w; } }
        if (STATS) {
#pragma unroll
            for (int bj = 0; bj < 2; ++bj)
#pragma unroll
                for (int j = 0; j < 8; ++j) { float s = psum[bj][j], q = psq[bj][j];
                    s += __shfl_xor(s, 1); s += __shfl_xor(s, 2); s += __shfl_xor(s, 4); s += __shfl_xor(s, 8);
                    q += __shfl_xor(q, 1); q += __shfl_xor(q, 2); q += __shfl_xor(q, 4); q += __shfl_xor(q, 8);
                    if (fr == 0) { const size_t si = (size_t)(col0 + bj * HALF + j) * 16 + u.pm * 2 + wr; vsum[si] = s; vsq[si] = q; } }
        }
    }
};
struct EpiResid {
    static constexpr bool PERM = true, AFTER_DRAIN = false;
    bf16_t* hbf; float* ssq; float* out32;
    __device__ __forceinline__ void prefetch(const Unit&, int, int) const {}
    __device__ __forceinline__ void operator()(const f32x4 (&acc)[2][2][4][2], const Unit& u, int wr, int wc, int fr, int fq) const {
        const int row0 = u.pm * BM + wr * 64 + fr, col0 = u.pn * BM + wc * 32 + 8 * fq;
        u32x4 pre[4][2]; float qs[2][4];
#pragma unroll
        for (int m = 0; m < 4; ++m) { const size_t off = (size_t)(row0 + m * 16) * 1024 + col0;
#pragma unroll
            for (int bj = 0; bj < 2; ++bj) pre[m][bj] = *(const u32x4*)(hbf + off + bj * HALF); }
#pragma unroll
        for (int ai = 0; ai < 2; ++ai)
#pragma unroll
            for (int m = 0; m < 4; ++m) { const int row = row0 + ai * HALF + m * 16; const size_t off = (size_t)row * 1024 + col0; float q = 0.f;
#pragma unroll
                for (int bj = 0; bj < 2; ++bj) { const u32x4 r = pre[m][bj];
                    const f32x4 b0 = (f32x4){__uint_as_float(r.x << 16), __uint_as_float(r.x & 0xffff0000u), __uint_as_float(r.y << 16), __uint_as_float(r.y & 0xffff0000u)};
                    const f32x4 b1 = (f32x4){__uint_as_float(r.z << 16), __uint_as_float(r.z & 0xffff0000u), __uint_as_float(r.w << 16), __uint_as_float(r.w & 0xffff0000u)};
                    const f32x4 v0 = acc[ai][bj][m][0] + b0, v1 = acc[ai][bj][m][1] + b1;
                    if (out32) { *(f32x4*)(out32 + off + bj * HALF) = v0; *(f32x4*)(out32 + off + bj * HALF + 4) = v1; }
                    u32x4 w; w.x = cvt_pk_bf16(v0[0], v0[1]); w.y = cvt_pk_bf16(v0[2], v0[3]); w.z = cvt_pk_bf16(v1[0], v1[1]); w.w = cvt_pk_bf16(v1[2], v1[3]);
                    *(u32x4*)(hbf + off + bj * HALF) = w;
                    q += (v0[0] * v0[0] + v0[1] * v0[1]) + (v0[2] * v0[2] + v0[3] * v0[3]) + (v1[0] * v1[0] + v1[1] * v1[1]) + (v1[2] * v1[2] + v1[3] * v1[3]); }
                qs[ai][m] = q;
                if (ai == 0) {
#pragma unroll
                    for (int bj = 0; bj < 2; ++bj) pre[m][bj] = *(const u32x4*)(hbf + off + (size_t)HALF * 1024 + bj * HALF);
                    asm volatile("" ::: "memory"); } }
#pragma unroll
        for (int ai = 0; ai < 2; ++ai)
#pragma unroll
            for (int m = 0; m < 4; ++m) qs[ai][m] += __shfl_xor(qs[ai][m], 16);
#pragma unroll
        for (int ai = 0; ai < 2; ++ai)
#pragma unroll
            for (int m = 0; m < 4; ++m) qs[ai][m] += __shfl_xor(qs[ai][m], 32);
        if (fq == 0) {
#pragma unroll
            for (int ai = 0; ai < 2; ++ai)
#pragma unroll
                for (int m = 0; m < 4; ++m) ssq[(size_t)(row0 + ai * HALF + m * 16) * 16 + u.pn * 4 + wc] = qs[ai][m]; }
    }
};
struct EpiNull {
    static constexpr bool PERM = true, AFTER_DRAIN = false;
    __device__ __forceinline__ void prefetch(const Unit&, int, int) const {}
    __device__ __forceinline__ void operator()(const f32x4 (&acc)[2][2][4][2], const Unit& u, int wr, int wc, int fr, int fq) const {
#pragma unroll
        for (int ai = 0; ai < 2; ++ai)
#pragma unroll
            for (int bj = 0; bj < 2; ++bj)
#pragma unroll
                for (int m = 0; m < 4; ++m)
#pragma unroll
                    for (int n = 0; n < 2; ++n) asm volatile("" :: "v"(acc[ai][bj][m][n]));
    }
};
}

constexpr size_t MiB = 1u << 20;
constexpr size_t WS_WIN = 0, WS_WOUT = 16 * MiB, WS_W1 = 24 * MiB, WS_W2 = 56 * MiB, WS_WQ = 88 * MiB, WS_WO = 92 * MiB, WS_WKV = 96 * MiB, WS_WC = 97 * MiB, WS_BIAS = 98 * MiB;
constexpr size_t WS_CTL = 99 * MiB, CTL_ZERO_BYTES = 32768;
constexpr size_t WS_SSQ = 100 * MiB, WS_VSUM = 102 * MiB, WS_VSQ = 106 * MiB, WS_HBF = 112 * MiB, WS_K = 176 * MiB, WS_VT = 192 * MiB, WS_R1 = 208 * MiB, WS_END = 464 * MiB;
constexpr int LDS_BYTES = 131072 + 256 + 16384;
constexpr int NTHREADS = 512;
constexpr int RP = 4096;

#define LAS __attribute__((address_space(3)))
typedef unsigned short bf16;
typedef unsigned u32x4 __attribute__((ext_vector_type(4)));
typedef unsigned u32x2 __attribute__((ext_vector_type(2)));
typedef float f32x4 __attribute__((ext_vector_type(4)));
typedef short bf16x8 __attribute__((ext_vector_type(8)));
typedef short s16x4 __attribute__((ext_vector_type(4)));

__device__ __forceinline__ unsigned pk2(float lo, float hi) { return pg8::cvt_pk_bf16(lo, hi); }
__device__ __forceinline__ float bf_lo(unsigned w) { return __uint_as_float(w << 16); }
__device__ __forceinline__ float bf_hi(unsigned w) { return __uint_as_float(w & 0xffff0000u); }
__device__ __forceinline__ float wave_sum(float v) {
#pragma unroll
    for (int o = 1; o < 64; o <<= 1) v += __shfl_xor(v, o);
    return v;
}

__device__ __forceinline__ void transpose_item(const float* W, int K, int N, const float* g, bf16* WT, LAS float* scr, int item, int lane) {
    const int nblk = N / 32, kb = item / nblk, nb = item % nblk, k0 = 64 * kb, n0 = 32 * nb;
    f32x4 w[8]; float gk[8];
#pragma unroll
    for (int i = 0; i < 8; ++i) { const int kk = 8 * i + (lane >> 3); w[i] = *(const f32x4*)(W + (size_t)(k0 + kk) * N + n0 + (lane & 7) * 4); gk[i] = g ? g[k0 + kk] : 1.0f; }
#pragma unroll
    for (int i = 0; i < 8; ++i) { const int kk = 8 * i + (lane >> 3); LAS float* d = scr + kk * 33 + (lane & 7) * 4;
        d[0] = w[i][0] * gk[i]; d[1] = w[i][1] * gk[i]; d[2] = w[i][2] * gk[i]; d[3] = w[i][3] * gk[i]; }
    asm volatile("s_waitcnt lgkmcnt(0)" ::: "memory");
    const int c = lane & 7;
#pragma unroll
    for (int j = 0; j < 4; ++j) { const int n = (lane >> 3) + 8 * j; const LAS float* s = scr + (8 * c) * 33 + n;
        u32x4 o; o.x = pk2(s[0 * 33], s[1 * 33]); o.y = pk2(s[2 * 33], s[3 * 33]); o.z = pk2(s[4 * 33], s[5 * 33]); o.w = pk2(s[6 * 33], s[7 * 33]);
        *(u32x4*)(WT + (size_t)(n0 + n) * K + k0 + 8 * c) = o; }
    asm volatile("s_waitcnt lgkmcnt(0)" ::: "memory");
}

struct Args {
    const float* x; const float* mix_g; const float* ffn_g; const float* a_w_in; const float* a_ln_g; const float* a_w_s; const float* a_b_s; const float* a_w_out;
    const float* kv_g; const float* w_k; const float* w_v; const float* b_w_q; const float* b_sinks; const float* b_w_o; const float* rel_bias; const float* ffn_w1; const float* ffn_w2; const float* final_g;
    float* out; unsigned char* ws;
};

__device__ __forceinline__ void prologue(const Args& a, LAS unsigned char* lds) {
    const int tid = opaque_tid(), lane = tid & 63, wave = tid >> 6;
    LAS float* scr = (LAS float*)(lds + wave * 16384);
    const int gw = blockIdx.x * 8 + wave, NGW = gridDim.x * 8;
    unsigned char* ws = a.ws;
    constexpr int I_IN = (D / 64) * (4096 / 32), I_OUT = (AW / 64) * (D / 32), I_1 = (D / 64) * (FF / 32), I_2 = (FF / 64) * (D / 32), I_Q = (D / 64) * (D / 32), I_KV = (D / 64) * (KVD / 32);
    constexpr int NITEMS = 2 * I_IN + 2 * I_OUT + 4 * I_1 + 4 * I_2 + 2 * I_Q + 2 * I_Q + 2 * I_KV;
    for (int it = gw; it < NITEMS; it += NGW) {
        int r = it;
#define TR(CNT, W, Kd, Nd, G, DST) if (r < (CNT)) { transpose_item((W), (Kd), (Nd), (G), (bf16*)(DST), scr, r, lane); continue; } r -= (CNT);
        TR(I_IN, a.a_w_in, D, 4096, a.mix_g, ws + WS_WIN)
        TR(I_IN, a.a_w_in + (size_t)D * 4096, D, 4096, a.mix_g + D, ws + WS_WIN + (size_t)D * 4096 * 2)
        TR(I_OUT, a.a_w_out, AW, D, nullptr, ws + WS_WOUT)
        TR(I_OUT, a.a_w_out + (size_t)AW * D, AW, D, nullptr, ws + WS_WOUT + (size_t)AW * D * 2)
        TR(I_1, a.ffn_w1 + 0 * (size_t)D * FF, D, FF, a.ffn_g + 0 * D, ws + WS_W1 + 0 * (size_t)D * FF * 2)
        TR(I_1, a.ffn_w1 + 1 * (size_t)D * FF, D, FF, a.ffn_g + 1 * D, ws + WS_W1 + 1 * (size_t)D * FF * 2)
        TR(I_1, a.ffn_w1 + 2 * (size_t)D * FF, D, FF, a.ffn_g + 2 * D, ws + WS_W1 + 2 * (size_t)D * FF * 2)
        TR(I_1, a.ffn_w1 + 3 * (size_t)D * FF, D, FF, a.ffn_g + 3 * D, ws + WS_W1 + 3 * (size_t)D * FF * 2)
        TR(I_2, a.ffn_w2 + 0 * (size_t)D * FF, FF, D, nullptr, ws + WS_W2 + 0 * (size_t)D * FF * 2)
        TR(I_2, a.ffn_w2 + 1 * (size_t)D * FF, FF, D, nullptr, ws + WS_W2 + 1 * (size_t)D * FF * 2)
        TR(I_2, a.ffn_w2 + 2 * (size_t)D * FF, FF, D, nullptr, ws + WS_W2 + 2 * (size_t)D * FF * 2)
        TR(I_2, a.ffn_w2 + 3 * (size_t)D * FF, FF, D, nullptr, ws + WS_W2 + 3 * (size_t)D * FF * 2)
        TR(I_Q, a.b_w_q, D, D, a.mix_g + 2 * D, ws + WS_WQ)
        TR(I_Q, a.b_w_q + (size_t)D * D, D, D, a.mix_g + 3 * D, ws + WS_WQ + (size_t)D * D * 2)
        TR(I_Q, a.b_w_o, D, D, nullptr, ws + WS_WO)
        TR(I_Q, a.b_w_o + (size_t)D * D, D, D, nullptr, ws + WS_WO + (size_t)D * D * 2)
        TR(I_KV, a.w_k, D, KVD, a.kv_g, ws + WS_WKV)
        TR(I_KV, a.w_v, D, KVD, a.kv_g, ws + WS_WKV + (size_t)D * KVD * 2)
#undef TR
    }
    {
        bf16* wc = (bf16*)(ws + WS_WC);
        const int gt = blockIdx.x * NTHREADS + tid, NT = gridDim.x * NTHREADS;
        for (int i = gt; i < 2 * NGRP * CHUNK * CHUNK / 2; i += NT) {
            const int e = 2 * i, col = e & 127, row = (e >> 7) & 127;
            const float w0 = (col <= row) ? a.a_w_s[e] : 0.f, w1 = (col + 1 <= row) ? a.a_w_s[e + 1] : 0.f;
            ((unsigned*)wc)[i] = pk2(w0, w1);
        }
        float* b2 = (float*)(ws + WS_BIAS);
        for (int i = gt; i < NH * 160; i += NT) {
            const int h = i / 160, d = i % 160 - 16; float val = -1e30f;
            if (d >= 0 && d < 128) { int bucket;
                if (d < 16) bucket = d;
                else { const float lr = logf((float)d / 16.0f) / logf(8.0f); int l = 16 + (int)(lr * 16.0f); bucket = l < 31 ? l : 31; }
                val = a.rel_bias[bucket * NH + h] * LOG2E; }
            b2[i] = val;
        }
    }
    {
        bf16* hbf = (bf16*)(ws + WS_HBF); float* ssq = (float*)(ws + WS_SSQ);
        for (int m0 = gw; m0 < T; m0 += 4 * NGW) {
            f32x4 v[4][4];
#pragma unroll
            for (int r = 0; r < 4; ++r) { const int m = m0 + r * NGW; if (m < T) { const f32x4* xr = (const f32x4*)(a.x + (size_t)m * D) + lane;
#pragma unroll
                    for (int j = 0; j < 4; ++j) v[r][j] = xr[64 * j]; } }
#pragma unroll
            for (int r = 0; r < 4; ++r) { const int m = m0 + r * NGW; if (m < T) { float s = 0.f;
#pragma unroll
                    for (int j = 0; j < 4; ++j) s += (v[r][j][0] * v[r][j][0] + v[r][j][1] * v[r][j][1]) + (v[r][j][2] * v[r][j][2] + v[r][j][3] * v[r][j][3]);
                    s = wave_sum(s);
                    u32x2* o8 = (u32x2*)(hbf + (size_t)m * D) + lane;
#pragma unroll
                    for (int j = 0; j < 4; ++j) { u32x2 w; w.x = pk2(v[r][j][0], v[r][j][1]); w.y = pk2(v[r][j][2], v[r][j][3]); o8[64 * j] = w; }
                    if (lane < 16) ssq[(size_t)m * 16 + lane] = (lane == 0) ? s : 0.f; } }
        }
    }
}

__device__ __forceinline__ int sgu_chunk(int unit, int G) {
    if (G != 256) return unit >> 3;
    const int i = unit >> 8, b0 = unit & 255, x = b0 & 7, r = b0 >> 3;
    return 32 * x + ((i < 4) ? 16 : 0) + (r >> 3) + 4 * (i & 3);
}
__device__ __forceinline__ int sgu_group(int unit, int G) { return (G != 256) ? (unit & 7) : (((unit & 255) >> 3) & 7); }
__device__ __forceinline__ s16x4 lds_tr(const LAS unsigned char* p) { typedef short v4i16_t __attribute__((ext_vector_type(4))); return __builtin_bit_cast(s16x4, __builtin_amdgcn_ds_read_tr16_b64_v4i16((LAS v4i16_t*)p)); }
__device__ __forceinline__ void sgu_phase(LAS unsigned char* lds, const bf16* WcBf, const float* lng, const float* bs, const bf16* v, bf16* u, const float* vsum, const float* vsq, bf16* dst, size_t dmask) {
    const int tid = opaque_tid(), wid = tid >> 6, lane = tid & 63, fr = lane & 15, fq = lane >> 4, wr = wid >> 2, wc = wid & 3;
    constexpr int BST = 576;
    LAS unsigned char* As = lds;
    LAS unsigned char* Bs = lds + 34816;
    LAS float* MU = (LAS float*)(lds + 34816 + 128 * BST); LAS float* RS = MU + 2048;
    const int NU = (T / CHUNK) * NGRP, G = gridDim.x, b0 = blockIdx.x;
    const int cnt = (b0 < NU) ? (NU - b0 + G - 1) / G : 0;
    const int c8 = (tid & 31) * 8, rbase = tid >> 5;
    int gprev = -1; float gc[8], bi[4];
    u32x4 rawB[8];
    for (int i0 = 0; i0 < cnt; i0 += 16) {
        const int c16 = (cnt - i0) < 16 ? (cnt - i0) : 16;
        __syncthreads();
        for (int idx = tid; idx < c16 * 128; idx += NTHREADS) { const int ui = idx >> 7, tk = idx & 127, n = sgu_chunk(b0 + G * (i0 + ui), G);
            const f32x4* ps = (const f32x4*)(vsum + (size_t)(n * CHUNK + tk) * 32); const f32x4* pq = (const f32x4*)(vsq + (size_t)(n * CHUNK + tk) * 32); float sm = 0.f, q = 0.f;
#pragma unroll
            for (int i = 0; i < 8; ++i) { const f32x4 a = ps[i], b = pq[i]; sm += (a[0] + a[1]) + (a[2] + a[3]); q += (b[0] + b[1]) + (b[2] + b[3]); }
            const float mean = sm * (1.0f / 2048.0f); float var = q * (1.0f / 2048.0f) - mean * mean; var = var > 0.f ? var : 0.f;
            MU[idx] = mean; RS[idx] = 1.0f / sqrtf(var + EPS); }
        {
            const int unit = b0 + G * i0, n = sgu_chunk(unit, G), g = sgu_group(unit, G);
#pragma unroll
            for (int i = 0; i < 8; ++i) rawB[i] = *(const u32x4*)(v + (size_t)(n * CHUNK + rbase + 16 * i) * RP + g * GDIM + c8);
        }
        for (int ii = 0; ii < c16; ++ii) {
            const int unit = b0 + G * (i0 + ii), n = sgu_chunk(unit, G), g = sgu_group(unit, G), tok0 = n * CHUNK;
            if (g != gprev) {
                gprev = g;
                const bf16* Ag = WcBf + (size_t)g * CHUNK * CHUNK;
#pragma unroll
                for (int i = 0; i < 4; ++i) { const int q = tid + 512 * i, r = q >> 4, cc = (q & 15) * 8; const u32x4 w = *(const u32x4*)(Ag + r * 128 + cc); *(LAS u32x4*)(As + r * 272 + cc * 2) = w; }
                const f32x4 g0 = *(const f32x4*)(lng + g * GDIM + c8), g1 = *(const f32x4*)(lng + g * GDIM + c8 + 4);
                gc[0] = g0[0]; gc[1] = g0[1]; gc[2] = g0[2]; gc[3] = g0[3]; gc[4] = g1[0]; gc[5] = g1[1]; gc[6] = g1[2]; gc[7] = g1[3];
#pragma unroll
                for (int m = 0; m < 4; ++m) bi[m] = bs[g * CHUNK + 64 * wr + 16 * m + fr];
            }
            if (ii == 0) __syncthreads();
#pragma unroll
            for (int i = 0; i < 8; ++i) { const int r = rbase + 16 * i; const u32x4 raw = rawB[i]; const float mu = MU[ii * 128 + r], rs = RS[ii * 128 + r];
                float y[8]; y[0] = bf_lo(raw.x); y[1] = bf_hi(raw.x); y[2] = bf_lo(raw.y); y[3] = bf_hi(raw.y); y[4] = bf_lo(raw.z); y[5] = bf_hi(raw.z); y[6] = bf_lo(raw.w); y[7] = bf_hi(raw.w);
#pragma unroll
                for (int j = 0; j < 8; ++j) y[j] = (y[j] - mu) * (rs * gc[j]);
                u32x4 w; w.x = pk2(y[0], y[1]); w.y = pk2(y[2], y[3]); w.z = pk2(y[4], y[5]); w.w = pk2(y[6], y[7]);
                *(LAS u32x4*)(Bs + r * BST + c8 * 2) = w; }
            __syncthreads();
            u32x4 ureg[4][2];
#pragma unroll
            for (int m = 0; m < 4; ++m)
#pragma unroll
                for (int p = 0; p < 2; ++p) ureg[m][p] = *(const u32x4*)(u + (size_t)(tok0 + 64 * wr + 16 * m + fr) * RP + g * GDIM + 64 * wc + 32 * p + 8 * fq);
            if (ii + 1 < c16) { const int un = unit + G, nn = sgu_chunk(un, G), gn = sgu_group(un, G);
#pragma unroll
                for (int i = 0; i < 8; ++i) rawB[i] = *(const u32x4*)(v + (size_t)(nn * CHUNK + rbase + 16 * i) * RP + gn * GDIM + c8); }
            f32x4 acc[4][4];
#pragma unroll
            for (int m = 0; m < 4; ++m)
#pragma unroll
                for (int nn = 0; nn < 4; ++nn) acc[m][nn] = (f32x4){0.f, 0.f, 0.f, 0.f};
            const int nk = wr ? 4 : 2;
            const LAS unsigned char* trb = Bs + (8 * fq + (fr >> 2)) * BST + (64 * wc + 8 * (fr & 3)) * 2;
            for (int kk = 0; kk < nk; ++kk) {
                bf16x8 af[4], bfr[4];
#pragma unroll
                for (int m = 0; m < 4; ++m) af[m] = *(const LAS bf16x8*)(As + (64 * wr + 16 * m + fr) * 272 + kk * 64 + fq * 16);
#pragma unroll
                for (int nn = 0; nn < 4; ++nn) { const LAS unsigned char* p0 = trb + kk * 32 * BST + (32 * (nn >> 1) + 4 * (nn & 1)) * 2;
                    const s16x4 lo = lds_tr(p0), hi = lds_tr(p0 + 4 * BST);
                    bfr[nn] = (bf16x8){lo[0], lo[1], lo[2], lo[3], hi[0], hi[1], hi[2], hi[3]}; }
#pragma unroll
                for (int m = 0; m < 4; ++m)
#pragma unroll
                    for (int nn = 0; nn < 4; ++nn) acc[m][nn] = __builtin_amdgcn_mfma_f32_16x16x32_bf16(bfr[nn], af[m], acc[m][nn], 0, 0, 0);
            }
#pragma unroll
            for (int m = 0; m < 4; ++m) { const int i = 64 * wr + 16 * m + fr; const float bb = bi[m];
#pragma unroll
                for (int p = 0; p < 2; ++p) { const u32x4 uv = ureg[m][p]; const f32x4 a0 = acc[m][2 * p], a1 = acc[m][2 * p + 1];
                    u32x4 w;
                    w.x = pk2(bf_lo(uv.x) * (a0[0] + bb), bf_hi(uv.x) * (a0[1] + bb)); w.y = pk2(bf_lo(uv.y) * (a0[2] + bb), bf_hi(uv.y) * (a0[3] + bb));
                    w.z = pk2(bf_lo(uv.z) * (a1[0] + bb), bf_hi(uv.z) * (a1[1] + bb)); w.w = pk2(bf_lo(uv.w) * (a1[2] + bb), bf_hi(uv.w) * (a1[3] + bb));
                    *(u32x4*)(dst + (((size_t)(tok0 + i) * RP + g * GDIM + 64 * wc + 32 * p + 8 * fq) & dmask)) = w; } }
            __syncthreads();
        }
    }
}

__device__ __forceinline__ void attn_phase(LAS unsigned char* lds, const bf16* Q, const bf16* Kb, const bf16* VT, bf16* O, const float* bias2, const float* sinks) {
    const int tid = opaque_tid(), wid = tid >> 6, lane = tid & 63, fr = lane & 15, fq = lane >> 4;
    LAS unsigned char* Ks = lds;
    LAS unsigned char* Vs = lds + 36864;
    LAS float* Bt = (LAS float*)(lds + 36864 + 33792);
    const int NU = BATCH * (SEQ / 128) * NKV, G = gridDim.x;
#define ATT_MAP(u_) ((G != 256) ? (u_) : ((((u_) & 255) & 7) * 128 + (((u_) & 255) >> 3) + 32 * (3 - ((u_) >> 8))))
    u32x4 kreg[4], vreg[4]; bf16x8 qreg[4][2]; float breg = 0.f, breg1 = 0.f;
#define ATT_ISSUE(unit_) do { const int kh_ = (unit_) & 3, nb_ = ((unit_) >> 2) & 31, b_ = (unit_) >> 7, tok0_ = b_ * SEQ + nb_ * 128, kt0_ = tok0_ - 128; \
        _Pragma("unroll") for (int i = 0; i < 4; ++i) { const int q = tid + 512 * i, r = q >> 3, c8 = (q & 7) * 8; u32x4 v = (u32x4){0u, 0u, 0u, 0u}; \
            if (nb_ > 0 || r >= 128) v = *(const u32x4*)(Kb + (size_t)(kt0_ + r) * KVD + kh_ * HD + c8); kreg[i] = v; } \
        _Pragma("unroll") for (int i = 0; i < 4; ++i) { const int q = tid + 512 * i, r = q >> 5, c8 = (q & 31) * 8; u32x4 v = (u32x4){0u, 0u, 0u, 0u}; \
            if (nb_ > 0 || c8 >= 128) v = *(const u32x4*)(VT + (size_t)(kh_ * HD + r) * T + kt0_ + c8); vreg[i] = v; } \
        breg = bias2[kh_ * 640 + tid]; if (tid < 128) breg1 = bias2[kh_ * 640 + 512 + tid]; } while (0)
#define ATT_ISSUE_Q(unit_) do { const int kh_ = (unit_) & 3, nb_ = ((unit_) >> 2) & 31, b_ = (unit_) >> 7, tok0_ = b_ * SEQ + nb_ * 128, hq_ = kh_ * 4 + (wid >> 1); \
          _Pragma("unroll") for (int grp = 0; grp < 4; ++grp) _Pragma("unroll") for (int kk = 0; kk < 2; ++kk) \
              qreg[grp][kk] = *(const bf16x8*)(Q + (size_t)(tok0_ + 64 * (wid & 1) + 16 * grp + fr) * RP + hq_ * HD + kk * 32 + fq * 8); } while (0)
    int unit = blockIdx.x;
    if (unit < NU) { const int cu0 = ATT_MAP(unit); ATT_ISSUE(cu0); ATT_ISSUE_Q(cu0); }
    for (; unit < NU; unit += G) {
        const int cu = ATT_MAP(unit), kh = cu & 3, nb = (cu >> 2) & 31, b = cu >> 7, tok0 = b * SEQ + nb * 128;
#pragma unroll
        for (int i = 0; i < 4; ++i) { const int q = tid + 512 * i, r = q >> 3, c8 = (q & 7) * 8; *(LAS u32x4*)(Ks + r * 144 + c8 * 2) = kreg[i]; }
#pragma unroll
        for (int i = 0; i < 4; ++i) { const int q = tid + 512 * i, r = q >> 5, c8 = (q & 31) * 8; *(LAS u32x4*)(Vs + r * 528 + c8 * 2) = vreg[i]; }
        Bt[tid] = breg; if (tid < 128) Bt[512 + tid] = breg1;
        __syncthreads();
        if (unit + G < NU) { const int cun = ATT_MAP(unit + G); ATT_ISSUE(cun); }
        const int hq = kh * 4 + (wid >> 1); const float sink2 = sinks[hq] * LOG2E;
        const LAS float* bt = Bt + (wid >> 1) * 160 + (fr - 4 * fq);
#pragma unroll
        for (int pr = 0; pr < 2; ++pr) {
            const int q0 = 64 * (wid & 1) + 32 * pr, tl = q0 >> 4;
            f32x4 SA[9], SB[9];
#define ATT_QK2(J0, J1) do { bf16x8 xk[(J1) - (J0)][2]; \
                _Pragma("unroll") for (int j = (J0); j < (J1); ++j) _Pragma("unroll") for (int kk = 0; kk < 2; ++kk) xk[j - (J0)][kk] = *(const LAS bf16x8*)(Ks + (16 * (tl + j) + fr) * 144 + kk * 64 + fq * 16); \
                __builtin_amdgcn_sched_barrier(0); \
                _Pragma("unroll") for (int kk = 0; kk < 2; ++kk) _Pragma("unroll") for (int j = (J0); j < (J1); ++j) { \
                    if (j <= 8) SA[j <= 8 ? j : 0] = __builtin_amdgcn_mfma_f32_16x16x32_bf16(xk[j - (J0)][kk], qreg[2 * pr][kk], kk == 0 ? (f32x4){0.f, 0.f, 0.f, 0.f} : SA[j <= 8 ? j : 0], 0, 0, 0); \
                    if (j >= 1) SB[j >= 1 ? j - 1 : 0] = __builtin_amdgcn_mfma_f32_16x16x32_bf16(xk[j - (J0)][kk], qreg[2 * pr + 1][kk], kk == 0 ? (f32x4){0.f, 0.f, 0.f, 0.f} : SB[j >= 1 ? j - 1 : 0], 0, 0, 0); } \
                __builtin_amdgcn_sched_barrier(0); } while (0)
            ATT_QK2(0, 3); ATT_QK2(3, 6); ATT_QK2(6, 8); ATT_QK2(8, 10);
#undef ATT_QK2
            float mxA = sink2, mxB = sink2;
#pragma unroll
            for (int t = 0; t < 9; ++t)
#pragma unroll
                for (int e = 0; e < 4; ++e) { const float bb = bt[144 - 16 * t - e]; const float la = SA[t][e] + bb, lb = SB[t][e] + bb; SA[t][e] = la; SB[t][e] = lb; mxA = fmaxf(mxA, la); mxB = fmaxf(mxB, lb); }
            mxA = fmaxf(mxA, __shfl_xor(mxA, 16)); mxB = fmaxf(mxB, __shfl_xor(mxB, 16)); mxA = fmaxf(mxA, __shfl_xor(mxA, 32)); mxB = fmaxf(mxB, __shfl_xor(mxB, 32));
            const int tinvA = (nb == 0) ? 8 - tl : 0, tinvB = (nb == 0) ? 7 - tl : 0;
            float lA = 0.f, lB = 0.f;
#pragma unroll
            for (int t = 0; t < 9; ++t) {
                if (t < tinvA) SA[t] = (f32x4){0.f, 0.f, 0.f, 0.f};
                else {
#pragma unroll
                    for (int e = 0; e < 4; ++e) { const float p = __builtin_amdgcn_exp2f(SA[t][e] - mxA); SA[t][e] = p; lA += p; } }
                if (t < tinvB) SB[t] = (f32x4){0.f, 0.f, 0.f, 0.f};
                else {
#pragma unroll
                    for (int e = 0; e < 4; ++e) { const float p = __builtin_amdgcn_exp2f(SB[t][e] - mxB); SB[t][e] = p; lB += p; } } }
            lA += __shfl_xor(lA, 16); lB += __shfl_xor(lB, 16); lA += __shfl_xor(lA, 32); lB += __shfl_xor(lB, 32);
            lA += __builtin_amdgcn_exp2f(sink2 - mxA); lB += __builtin_amdgcn_exp2f(sink2 - mxB);
            bf16x8 ypA[5], ypB[5];
#pragma unroll
            for (int pp = 0; pp < 5; ++pp) { const f32x4 z = (f32x4){0.f, 0.f, 0.f, 0.f};
                const f32x4 loA = SA[2 * pp], hiA = (2 * pp + 1 <= 8) ? SA[(2 * pp + 1 <= 8) ? 2 * pp + 1 : 0] : z;
                const f32x4 loB = (2 * pp >= 1) ? SB[(2 * pp >= 1) ? 2 * pp - 1 : 0] : z, hiB = SB[2 * pp];
                u32x4 w; w.x = pk2(loA[0], loA[1]); w.y = pk2(loA[2], loA[3]); w.z = pk2(hiA[0], hiA[1]); w.w = pk2(hiA[2], hiA[3]); ypA[pp] = __builtin_bit_cast(bf16x8, w);
                w.x = pk2(loB[0], loB[1]); w.y = pk2(loB[2], loB[3]); w.z = pk2(hiB[0], hiB[1]); w.w = pk2(hiB[2], hiB[3]); ypB[pp] = __builtin_bit_cast(bf16x8, w); }
            f32x4 OaA[4], OaB[4];
#define ATT_PV2(D0) do { s16x4 va[5], vb[5]; \
                _Pragma("unroll") for (int pp = 0; pp < 5; ++pp) { \
                    va[pp] = *(const LAS s16x4*)(Vs + (16 * (D0) + fr) * 528 + (16 * (tl + 2 * pp) + 4 * fq) * 2); vb[pp] = *(const LAS s16x4*)(Vs + (16 * (D0) + fr) * 528 + (16 * (tl + 2 * pp + 1) + 4 * fq) * 2); } \
                __builtin_amdgcn_sched_barrier(0); \
                OaA[(D0)] = (f32x4){0.f, 0.f, 0.f, 0.f}; OaB[(D0)] = (f32x4){0.f, 0.f, 0.f, 0.f}; \
                _Pragma("unroll") for (int pp = 0; pp < 5; ++pp) { \
                    const bf16x8 xv = (bf16x8){va[pp][0], va[pp][1], va[pp][2], va[pp][3], vb[pp][0], vb[pp][1], vb[pp][2], vb[pp][3]}; \
                    OaA[(D0)] = __builtin_amdgcn_mfma_f32_16x16x32_bf16(xv, ypA[pp], OaA[(D0)], 0, 0, 0); \
                    OaB[(D0)] = __builtin_amdgcn_mfma_f32_16x16x32_bf16(xv, ypB[pp], OaB[(D0)], 0, 0, 0); } \
                __builtin_amdgcn_sched_barrier(0); } while (0)
            ATT_PV2(0); ATT_PV2(1); ATT_PV2(2); ATT_PV2(3);
#undef ATT_PV2
            const float invA = 1.0f / lA, invB = 1.0f / lB;
            bf16* opA = O + (size_t)(tok0 + q0 + fr) * RP + hq * HD + 4 * fq; bf16* opB = opA + (size_t)16 * RP;
#pragma unroll
            for (int dt = 0; dt < 4; ++dt) { u32x2 w; w.x = pk2(OaA[dt][0] * invA, OaA[dt][1] * invA); w.y = pk2(OaA[dt][2] * invA, OaA[dt][3] * invA); *(u32x2*)(opA + 16 * dt) = w;
                w.x = pk2(OaB[dt][0] * invB, OaB[dt][1] * invB); w.y = pk2(OaB[dt][2] * invB, OaB[dt][3] * invB); *(u32x2*)(opB + 16 * dt) = w; }
        }
        if (unit + G < NU) { const int cun = ATT_MAP(unit + G); ATT_ISSUE_Q(cun); }
        __syncthreads();
    }
#undef ATT_ISSUE_Q
#undef ATT_MAP
#undef ATT_ISSUE
}

__device__ __forceinline__ void final_norm(float* out, const bf16* hbf, const float* ssq, const float* g) {
    const int tid = opaque_tid(), lane = tid & 63, wave = tid >> 6;
    const int gw = blockIdx.x * 8 + wave, NGW = gridDim.x * 8;
    f32x4 gv[4];
#pragma unroll
    for (int j = 0; j < 4; ++j) gv[j] = ((const f32x4*)g)[lane + 64 * j];
#define FN_ROW(L_) ((gridDim.x != 256) ? (L_) : ((((L_) & 2047) >> 3) & 7) * 4096 + (((((L_) & 2047) >> 3) >> 3) * 8 + ((L_) & 7)) + 256 * ((L_) >> 11))
    for (int m0 = gw; m0 < T; m0 += 4 * NGW) {
        u32x2 hv[4][4]; float sp[4];
#pragma unroll
        for (int r = 0; r < 4; ++r) { const int m = FN_ROW(m0 + r * NGW); if (m < T) { sp[r] = ssq[(size_t)m * 16 + (lane & 15)];
#pragma unroll
                for (int j = 0; j < 4; ++j) hv[r][j] = ((const u32x2*)(hbf + (size_t)m * D))[lane + 64 * j]; } }
#pragma unroll
        for (int r = 0; r < 4; ++r) { const int m = FN_ROW(m0 + r * NGW); if (m < T) { float s = sp[r];
                s += __shfl_xor(s, 1); s += __shfl_xor(s, 2); s += __shfl_xor(s, 4); s += __shfl_xor(s, 8);
                const float rr = __builtin_amdgcn_rsqf(s * (1.0f / 1024.0f) + EPS);
                f32x4* xr = (f32x4*)(out + (size_t)m * D) + lane;
#pragma unroll
                for (int j = 0; j < 4; ++j) { f32x4 v = (f32x4){bf_lo(hv[r][j].x), bf_hi(hv[r][j].x), bf_lo(hv[r][j].y), bf_hi(hv[r][j].y)}; v = v * rr * gv[j]; xr[64 * j] = v; } } }
    }
}

#define XB_TMO      128
#define XB_XCNT(j)  (256  + 64 * (j))
#define XB_XSUB(j)  (1280 + 64 * (j))
#define XB_XGEN(j)  (2304 + 64 * (j))
#define XB_TOP      3328
#define XB_TOPGEN   3392
#define XCD_BAR_WORDS 3456
#define XB_SPIN_CAP (1u << 18)

__device__ __forceinline__ unsigned xb_ld(unsigned* p)              { return __hip_atomic_load(p, __ATOMIC_RELAXED, __HIP_MEMORY_SCOPE_AGENT); }
__device__ __forceinline__ unsigned xb_add(unsigned* p, unsigned v) { return __hip_atomic_fetch_add(p, v, __ATOMIC_RELAXED, __HIP_MEMORY_SCOPE_AGENT); }
__device__ __forceinline__ unsigned xb_xcc_id() { return (unsigned)__builtin_amdgcn_s_getreg((3 << 11) | 20) & 0xFu; }
#define XB_SPIN(cond, bar) do { unsigned _sp = 0; while (cond) { __builtin_amdgcn_s_sleep(1); \
    if ((++_sp & 255u) == 0u) { if (xb_ld(&(bar)[XB_TMO])) break; if (_sp > XB_SPIN_CAP) { atomicAdd(&(bar)[XB_TMO], 1u); break; } } } } while (0)

struct XcdBarrier {
    unsigned* bar; unsigned x;
    volatile LAS unsigned* st;
};

__device__ __forceinline__ XcdBarrier xcd_barrier_post(unsigned* bar, volatile LAS unsigned* st) {
    XcdBarrier b; b.bar = bar; b.x = xb_xcc_id(); b.st = st;
    if (threadIdx.x == 0) (void)xb_add(&bar[XB_XCNT(b.x)], 1u);
    return b;
}
__device__ __forceinline__ void xcd_barrier_complete(unsigned* bar, unsigned x, unsigned& nloc, unsigned& nx) {
    const unsigned G = gridDim.x * gridDim.y * gridDim.z;
    unsigned sum, cnt, mine, sp = 0u;
    for (;;) {
        sum = 0u; cnt = 0u; mine = 0u;
#pragma unroll
        for (unsigned j = 0; j < 16; ++j) { const unsigned c = xb_ld(&bar[XB_XCNT(j)]); sum += c; cnt += (c > 0u) ? 1u : 0u; mine = (j == x) ? c : mine; }
        if (sum == G) break;
        __builtin_amdgcn_s_sleep(1);
        if ((++sp & 255u) == 0u) { if (xb_ld(&bar[XB_TMO])) break; if (sp > XB_SPIN_CAP) { atomicAdd(&bar[XB_TMO], 1u); break; } }
    }
    nloc = mine > 0u ? mine : 1u; nx = cnt > 0u ? cnt : 1u;
}

__device__ __forceinline__ void xcd_barrier(const XcdBarrier& b) {
    asm volatile("s_waitcnt vmcnt(0)" ::: "memory");
    __syncthreads();
    if (threadIdx.x == 0) {
        unsigned* bar = b.bar;
        __builtin_amdgcn_s_waitcnt(0);
        unsigned nloc = b.st[0], nx = b.st[1];
        if (nloc == 0u) { xcd_barrier_complete(bar, b.x, nloc, nx); b.st[0] = nloc; b.st[1] = nx; }
        const unsigned old = xb_add(&bar[XB_XSUB(b.x)], 1u);
        const unsigned gen = old / nloc;
        if (old + 1u == (gen + 1u) * nloc) {
            __builtin_amdgcn_fence(__ATOMIC_RELEASE, "agent");
            asm volatile("s_waitcnt vmcnt(0)" ::: "memory");
            const unsigned og = xb_add(&bar[XB_TOP], 1u);
            const unsigned tg = og / nx;
            if (og + 1u == (tg + 1u) * nx) xb_add(&bar[XB_TOPGEN], 1u);
            else XB_SPIN(xb_ld(&bar[XB_TOPGEN]) == tg, bar);
            __builtin_amdgcn_fence(__ATOMIC_ACQUIRE, "agent");
            xb_add(&bar[XB_XGEN(b.x)], 1u);
            asm volatile("s_waitcnt vmcnt(0)" ::: "memory");
        } else {
            XB_SPIN(xb_ld(&bar[XB_XGEN(b.x)]) == gen, bar);
            __builtin_amdgcn_fence(__ATOMIC_ACQUIRE, "agent");
            asm volatile("s_waitcnt vmcnt(0)" ::: "memory");
        }
    }
    __syncthreads();
}


#define XB_LSUB(j)  (3456 + 64 * (j))
#define XB_LGEN(j)  (4480 + 64 * (j))
#define XB_CLSHI(k) (5632 + 64 * (k))
#define XB_CLSLO(k) (6144 + 64 * (k))
__device__ __forceinline__ void xcd_local_barrier(const XcdBarrier& b, unsigned nloc) {
    asm volatile("s_waitcnt vmcnt(0)" ::: "memory");
    __syncthreads();
    if (threadIdx.x == 0) {
        unsigned* bar = b.bar;
        __builtin_amdgcn_s_waitcnt(0);
        const unsigned old = xb_add(&bar[XB_LSUB(b.x)], 1u);
        const unsigned gen = old / nloc;
        if (old + 1u == (gen + 1u) * nloc) xb_add(&bar[XB_LGEN(b.x)], 1u);
        else XB_SPIN(xb_ld(&bar[XB_LGEN(b.x)]) == gen, bar);
        __builtin_amdgcn_fence(__ATOMIC_ACQUIRE, "agent");
        asm volatile("s_waitcnt vmcnt(0)" ::: "memory");
    }
    __syncthreads();
}

struct OneUnit { pg8::Unit u;
    __device__ __forceinline__ bool next(int i, pg8::Unit& o) const { if (i) return false; o = u; return true; }
    __device__ __forceinline__ void a_ready(const pg8::Unit&) const {}
    __device__ __forceinline__ void done(const pg8::Unit&) const {} };
struct EpiSgu {
    static constexpr bool PERM = true, AFTER_DRAIN = true;
    bf16* U; const bf16* V; const float* ssq; const float* vsum; const float* vsq; const bf16* WcBf; const float* lng; const float* bs; LAS float* tab;
    __device__ __forceinline__ void prefetch(const pg8::Unit& u, int wid, int lane) const { pg8::ssq_prefetch(tab, ssq, u.pm, wid, lane); }
    __device__ __forceinline__ void fused(f32x4 (&acc)[2][2][4][2], const pg8::Unit& u, int wr, int wc, int fr, int fq, LAS unsigned char* lds, int wid, int lane) const {
        const int tid = wid * 64 + lane, g = u.pn;
        constexpr int BST = 576;
        LAS unsigned char* As = lds;
        LAS unsigned char* Bs = lds + 34816;
        LAS float* MU = (LAS float*)(lds + 34816 + 128 * BST); LAS float* RS = MU + 128;
        {
            float rs[2][4]; pg8::row_rstd_lds(rs, tab, wr * 64 + fr, fq, 1.0f);
#pragma unroll
            for (int ai = 0; ai < 2; ++ai)
#pragma unroll
                for (int m = 0; m < 4; ++m)
#pragma unroll
                    for (int bj = 0; bj < 2; ++bj) { f32x4 v0 = acc[ai][bj][m][0] * rs[ai][m], v1 = acc[ai][bj][m][1] * rs[ai][m];
                        const pg8::f32x2 a = pg8::gelu_pk((pg8::f32x2){v0[0], v0[1]}), b = pg8::gelu_pk((pg8::f32x2){v0[2], v0[3]}), c = pg8::gelu_pk((pg8::f32x2){v1[0], v1[1]}), d = pg8::gelu_pk((pg8::f32x2){v1[2], v1[3]});
                        acc[ai][bj][m][0] = (f32x4){a.x, a.y, b.x, b.y}; acc[ai][bj][m][1] = (f32x4){c.x, c.y, d.x, d.y}; }
        }
        {
            const bf16* Ag = WcBf + (size_t)g * CHUNK * CHUNK;
#pragma unroll
            for (int i = 0; i < 4; ++i) { const int q = tid + 512 * i, r = q >> 4, cc = (q & 15) * 8; const u32x4 w = *(const u32x4*)(Ag + r * 128 + cc); *(LAS u32x4*)(As + r * 272 + cc * 2) = w; }
        }
        const int c8 = (tid & 31) * 8, rbase = tid >> 5;
        float gc[8];
        { const f32x4 g0 = *(const f32x4*)(lng + g * GDIM + c8), g1 = *(const f32x4*)(lng + g * GDIM + c8 + 4);
          gc[0] = g0[0]; gc[1] = g0[1]; gc[2] = g0[2]; gc[3] = g0[3]; gc[4] = g1[0]; gc[5] = g1[1]; gc[6] = g1[2]; gc[7] = g1[3]; }
        float bi[4];
#pragma unroll
        for (int m = 0; m < 4; ++m) bi[m] = bs[g * CHUNK + 64 * wr + 16 * m + fr];
        const int nk = wr ? 4 : 2;
#pragma unroll
        for (int ai = 0; ai < 2; ++ai) {
            const int tok0 = (u.pm * 2 + ai) * CHUNK;
            u32x4 rawB[8];
#pragma unroll
            for (int i = 0; i < 8; ++i) rawB[i] = *(const u32x4*)(V + (size_t)(tok0 + rbase + 16 * i) * RP + g * GDIM + c8);
            {
                const int tk = tid >> 2, qd = tid & 3;
                const f32x4* ps = (const f32x4*)(vsum + (size_t)(tok0 + tk) * 32 + qd * 8); const f32x4* pq = (const f32x4*)(vsq + (size_t)(tok0 + tk) * 32 + qd * 8);
                const f32x4 a0 = ps[0], a1 = ps[1], b0 = pq[0], b1 = pq[1];
                float sm = ((a0[0] + a0[1]) + (a0[2] + a0[3])) + ((a1[0] + a1[1]) + (a1[2] + a1[3])), q = ((b0[0] + b0[1]) + (b0[2] + b0[3])) + ((b1[0] + b1[1]) + (b1[2] + b1[3]));
                sm += __shfl_xor(sm, 1); q += __shfl_xor(q, 1); sm += __shfl_xor(sm, 2); q += __shfl_xor(q, 2);
                const float mean = sm * (1.0f / 2048.0f); float var = q * (1.0f / 2048.0f) - mean * mean; var = var > 0.f ? var : 0.f;
                if (qd == 0) { MU[tk] = mean; RS[tk] = 1.0f / sqrtf(var + EPS); }
            }
            __syncthreads();
#pragma unroll
            for (int i = 0; i < 8; ++i) { const int r = rbase + 16 * i; const u32x4 raw = rawB[i]; const float mu = MU[r], rsd = RS[r];
                float y[8]; y[0] = bf_lo(raw.x); y[1] = bf_hi(raw.x); y[2] = bf_lo(raw.y); y[3] = bf_hi(raw.y); y[4] = bf_lo(raw.z); y[5] = bf_hi(raw.z); y[6] = bf_lo(raw.w); y[7] = bf_hi(raw.w);
#pragma unroll
                for (int j = 0; j < 8; ++j) y[j] = (y[j] - mu) * (rsd * gc[j]);
                u32x4 w; w.x = pk2(y[0], y[1]); w.y = pk2(y[2], y[3]); w.z = pk2(y[4], y[5]); w.w = pk2(y[6], y[7]);
                *(LAS u32x4*)(Bs + r * BST + c8 * 2) = w; }
            __syncthreads();
#pragma unroll
            for (int bj = 0; bj < 2; ++bj) {
                f32x4 mix[4][2];
#pragma unroll
                for (int m = 0; m < 4; ++m) { mix[m][0] = (f32x4){0.f, 0.f, 0.f, 0.f}; mix[m][1] = (f32x4){0.f, 0.f, 0.f, 0.f}; }
                const LAS unsigned char* trb = Bs + (8 * fq + (fr >> 2)) * BST + (128 * bj + 32 * wc + 8 * (fr & 3)) * 2;
                for (int kk = 0; kk < nk; ++kk) {
                    bf16x8 af[4], bfr[2];
#pragma unroll
                    for (int m = 0; m < 4; ++m) af[m] = *(const LAS bf16x8*)(As + (64 * wr + 16 * m + fr) * 272 + kk * 64 + fq * 16);
#pragma unroll
                    for (int n = 0; n < 2; ++n) { const LAS unsigned char* p0 = trb + kk * 32 * BST + 4 * n * 2; const s16x4 lo = lds_tr(p0), hi = lds_tr(p0 + 4 * BST);
                        bfr[n] = (bf16x8){lo[0], lo[1], lo[2], lo[3], hi[0], hi[1], hi[2], hi[3]}; }
#pragma unroll
                    for (int m = 0; m < 4; ++m)
#pragma unroll
                        for (int n = 0; n < 2; ++n) mix[m][n] = __builtin_amdgcn_mfma_f32_16x16x32_bf16(bfr[n], af[m], mix[m][n], 0, 0, 0);
                }
#pragma unroll
                for (int m = 0; m < 4; ++m) { const float bb = bi[m]; const f32x4 a0 = acc[ai][bj][m][0], a1 = acc[ai][bj][m][1], m0 = mix[m][0], m1 = mix[m][1];
                    u32x4 w; w.x = pk2(a0[0] * (m0[0] + bb), a0[1] * (m0[1] + bb)); w.y = pk2(a0[2] * (m0[2] + bb), a0[3] * (m0[3] + bb));
                    w.z = pk2(a1[0] * (m1[0] + bb), a1[1] * (m1[1] + bb)); w.w = pk2(a1[2] * (m1[2] + bb), a1[3] * (m1[3] + bb));
                    *(u32x4*)(U + (size_t)(tok0 + 64 * wr + 16 * m + fr) * RP + g * GDIM + 128 * bj + 32 * wc + 8 * fq) = w; }
            }
        }
        __syncthreads();
    }
};
#ifndef STAGGER_MODE
#define STAGGER_MODE 0
#endif
#ifndef STAGGER_TICKS
#define STAGGER_TICKS 300
#endif
__device__ __forceinline__ void stagger_delay(int k) {
    if (k > 0) { const unsigned long long t0 = __builtin_amdgcn_s_memrealtime(); const unsigned long long want = (unsigned long long)k * STAGGER_TICKS;
        while (__builtin_amdgcn_s_memrealtime() - t0 < want) __builtin_amdgcn_s_sleep(8); }
}
#ifndef PROBE_U2
#define PROBE_U2 0
#endif
#ifndef PROBE_V2
#define PROBE_V2 0
#endif
#ifndef PROBE_Q2
#define PROBE_Q2 0
#endif
#ifndef PROBE_SYNC2
#define PROBE_SYNC2 0
#endif
#ifndef PROBE_ATT2
#define PROBE_ATT2 0
#endif
#ifndef PROBE_SGU2
#define PROBE_SGU2 0
#endif
#ifndef PROBE_PRO2
#define PROBE_PRO2 0
#endif
#ifndef PROBE_FFN2X
#define PROBE_FFN2X 0
#endif
#define GSYNC() do { if (fast) xcd_local_barrier(bar, 32u); else xcd_barrier(bar); if (PROBE_SYNC2) { if (fast) xcd_local_barrier(bar, 32u); else xcd_barrier(bar); } } while (0)
#ifndef PHASE_MASK
#define PHASE_MASK 0xFFFF
#endif
#define PH(b) if constexpr ((PHASE_MASK >> (b)) & 1)
__global__ void __launch_bounds__(NTHREADS, 2) fwd_megakernel(Args a) {
    extern __shared__ __attribute__((aligned(16))) unsigned char lds_raw[];
    LAS unsigned char* lds = (LAS unsigned char*)lds_raw;
    cg::grid_group grid = cg::this_grid();
    unsigned char* ws = a.ws;
    const int G = gridDim.x, c = blockIdx.x;
    bf16* hbf = (bf16*)(ws + WS_HBF); float* ssq = (float*)(ws + WS_SSQ); float* vsum = (float*)(ws + WS_VSUM); float* vsq = (float*)(ws + WS_VSQ);
    bf16* R1 = (bf16*)(ws + WS_R1);
    LAS float* TAB = (LAS float*)(lds + 131072 + 256);

    volatile LAS unsigned* MISC = (volatile LAS unsigned*)(lds + 131072);
    if (threadIdx.x < 16) MISC[threadIdx.x] = 0u;
    __syncthreads();
    XcdBarrier bar = xcd_barrier_post((unsigned*)(ws + WS_CTL), MISC + 8);
    if (threadIdx.x == 0) {
        __hip_atomic_fetch_max(&bar.bar[XB_CLSHI(blockIdx.x & 7u)], bar.x + 1u, __ATOMIC_RELAXED, __HIP_MEMORY_SCOPE_AGENT);
        __hip_atomic_fetch_max(&bar.bar[XB_CLSLO(blockIdx.x & 7u)], 16u - bar.x, __ATOMIC_RELAXED, __HIP_MEMORY_SCOPE_AGENT); }
    PH(0) prologue(a, lds);
    if (PROBE_PRO2) prologue(a, lds);
    grid.sync();
    bool fast = (G == 256);
#pragma unroll
    for (unsigned k = 0; k < 8; ++k) { const unsigned hi = xb_ld(&bar.bar[XB_CLSHI(k)]), lo = xb_ld(&bar.bar[XB_CLSLO(k)]); fast = fast && (hi >= 1u) && (hi - 1u == 16u - lo); }
#pragma unroll
    for (unsigned j = 0; j < 16; ++j) { const unsigned cx = xb_ld(&bar.bar[XB_XCNT(j)]); fast = fast && (cx == 0u || cx == 32u); }
    fast = __builtin_amdgcn_readfirstlane(fast ? 1 : 0) != 0;
#if defined(PROBE_FORCE_FAST)
    fast = true;
#endif

    for (int layer = 0; layer < 4; ++layer) {
        const bf16* mixA; const bf16* mixW; int mixK;
        if (layer < 2) {
            const bf16* Win = (const bf16*)(ws + WS_WIN) + (size_t)layer * 4096 * D;
            bf16* U = R1; bf16* VTt = R1 + AW;
            PH(1) {
                pg8::Gemm g{hbf, Win + (size_t)AW * D, T, AW, D, D}; pg8::StaticOrder S; S.init(T, AW, G, c);
                pg8::EpiRowAct<1, 0, true> E{U, RP, ssq, 1.0f, VTt, 0, vsum, vsq, TAB};
                pg8::gemm_phase<pg8::EpiRowAct<1, 0, true>, pg8::StaticOrder, true, true>(lds, g, S, E);
            }
            GSYNC();
            PH(3) {
                pg8::Gemm g{hbf, Win, T, AW, D, D}; pg8::StaticOrder S; S.init(T, AW, G, c);
                EpiSgu E{U, VTt, ssq, vsum, vsq, (const bf16*)(ws + WS_WC) + (size_t)layer * NGRP * CHUNK * CHUNK, a.a_ln_g + (size_t)layer * AW, a.a_b_s + (size_t)layer * NGRP * CHUNK, TAB};
                pg8::Unit uu;
                for (int i = 0; S.next(i, uu); ++i) { OneUnit O{uu}; pg8::gemm_phase<EpiSgu, OneUnit, false, true>(lds, g, O, E); }
            }
            GSYNC();
            mixA = U; mixW = (const bf16*)(ws + WS_WOUT) + (size_t)layer * D * AW; mixK = AW;
        } else {
            const int j = layer - 2;
            bf16* Qb = R1; bf16* Ob = R1 + D;
            bf16* Kb = (bf16*)(ws + WS_K); bf16* VTb = (bf16*)(ws + WS_VT);
            PH(4) {
                pg8::Gemm g{hbf, (const bf16*)(ws + WS_WQ) + (size_t)j * D * D, T, D, D, D}; pg8::StaticOrder S; S.init(T, D, G, c);
                pg8::EpiRowAct<0> E{Qb, RP, ssq, QSCALE, nullptr, 0, nullptr, nullptr, TAB};
                pg8::gemm_phase<pg8::EpiRowAct<0>, pg8::StaticOrder, true, true>(lds, g, S, E);
            }
            if (layer == 2) {
                PH(5) {
                    pg8::Gemm g{hbf, (const bf16*)(ws + WS_WKV), T, KVD, D, D}; pg8::StaticOrder S; S.init(T, KVD, G, c);
                    pg8::EpiRowAct<0> E{Kb, KVD, ssq, 1.0f, nullptr, 0, nullptr, nullptr, TAB};
                    pg8::gemm_phase<pg8::EpiRowAct<0>, pg8::StaticOrder, true, true>(lds, g, S, E);
                }
                PH(6) {
                    pg8::Gemm g{(const bf16*)(ws + WS_WKV) + (size_t)D * KVD, hbf, KVD, T, D, D}; pg8::StaticOrder S; S.init(KVD, T, G, (c + G / 2) % G);
                    pg8::EpiColAct<0, false> E{VTb, T, ssq, nullptr, nullptr};
                    pg8::gemm_phase<pg8::EpiColAct<0, false>, pg8::StaticOrder, true, true>(lds, g, S, E);
                }
            }
            GSYNC();
            if (PROBE_ATT2) attn_phase(lds, Qb, Kb, VTb, Ob, (const float*)(ws + WS_BIAS), a.b_sinks + j * NH);
            PH(7) attn_phase(lds, Qb, Kb, VTb, Ob, (const float*)(ws + WS_BIAS), a.b_sinks + j * NH);
            GSYNC();
            mixA = Ob; mixW = (const bf16*)(ws + WS_WO) + (size_t)j * D * D; mixK = D;
        }
        PH(8) {
            pg8::Gemm g{mixA, mixW, T, D, mixK, RP}; pg8::StaticOrder S; S.init(T, D, G, c);
            pg8::EpiResid E{hbf, ssq, nullptr};
            pg8::gemm_phase<pg8::EpiResid, pg8::StaticOrder, true, true>(lds, g, S, E);
        }
        GSYNC();
        bf16* Fb = R1;
        PH(9) {
            pg8::Gemm g{hbf, (const bf16*)(ws + WS_W1) + (size_t)layer * D * FF, T, FF, D, D}; pg8::StaticOrder S; S.init(T, FF, G, c);
            pg8::EpiRowAct<2> E{Fb, FF, ssq, 1.0f, nullptr, 0, nullptr, nullptr, TAB};
            if (STAGGER_MODE == 1) stagger_delay(c & 7); else if (STAGGER_MODE == 2) stagger_delay((c >> 3) & 7);
            if (PROBE_FFN2X == 1) pg8::gemm_phase<pg8::EpiRowAct<2>, pg8::StaticOrder, true, true>(lds, g, S, E);
            if (PROBE_FFN2X == 3) { pg8::EpiRowAct<2, 1> E1{Fb, FF, ssq, 1.0f, nullptr, 0, nullptr, nullptr, TAB}; pg8::gemm_phase<pg8::EpiRowAct<2, 1>, pg8::StaticOrder, true, true>(lds, g, S, E1); }
            if (PROBE_FFN2X == 4) { pg8::EpiRowAct<2, 2> E2{Fb, FF, ssq, 1.0f, nullptr, 0, nullptr, nullptr, TAB}; pg8::gemm_phase<pg8::EpiRowAct<2, 2>, pg8::StaticOrder, true, true>(lds, g, S, E2); }
            if (PROBE_FFN2X == 2) { pg8::EpiNull EN{}; pg8::gemm_phase<pg8::EpiNull, pg8::StaticOrder, true, true>(lds, g, S, EN); }
            pg8::gemm_phase<pg8::EpiRowAct<2>, pg8::StaticOrder, true, true>(lds, g, S, E);
        }
        GSYNC();
        PH(10) {
            pg8::Gemm g{Fb, (const bf16*)(ws + WS_W2) + (size_t)layer * D * FF, T, D, FF, FF}; pg8::StaticOrder S; S.init(T, D, G, c);
            pg8::EpiResid E{hbf, ssq, nullptr};
            pg8::gemm_phase<pg8::EpiResid, pg8::StaticOrder, true, true>(lds, g, S, E);
        }
        GSYNC();
    }
    PH(11) final_norm(a.out, hbf, ssq, a.final_g);
}

extern "C" void kernel_launch(void* const* d_in, const int* in_sizes, int n_in, void* d_out, int out_size, void* d_ws, size_t ws_size, hipStream_t stream) {
    static int grid = 0;
    if (grid == 0) {
        if (n_in != 18 || in_sizes[0] != T * D || out_size != T * D || ws_size < WS_END) { fprintf(stderr, "kernel_launch: unexpected shapes (n_in %d in0 %d out %d ws %zu)\n", n_in, n_in > 0 ? in_sizes[0] : -1, out_size, ws_size); grid = -1; return; }
        int dev = 0, cus = 0, per_cu = 0;
        hipGetDevice(&dev); hipDeviceGetAttribute(&cus, hipDeviceAttributeMultiprocessorCount, dev);
        if (hipFuncSetAttribute((const void*)fwd_megakernel, hipFuncAttributeMaxDynamicSharedMemorySize, LDS_BYTES) != hipSuccess) { fprintf(stderr, "kernel_launch: hipFuncSetAttribute failed\n"); grid = -1; return; }
        if (hipOccupancyMaxActiveBlocksPerMultiprocessor(&per_cu, (const void*)fwd_megakernel, NTHREADS, LDS_BYTES) != hipSuccess || per_cu < 1) { fprintf(stderr, "kernel_launch: occupancy query says %d\n", per_cu); per_cu = 1; }
        (void)hipGetLastError();
        grid = cus * 1;
    }
    if (grid < 0) return;
    if (hipMemsetAsync((char*)d_ws + WS_CTL, 0, CTL_ZERO_BYTES, stream) != hipSuccess) { fprintf(stderr, "kernel_launch: memset failed\n"); return; }
    Args a{};
    a.x = (const float*)d_in[0]; a.mix_g = (const float*)d_in[1]; a.ffn_g = (const float*)d_in[2]; a.a_w_in = (const float*)d_in[3]; a.a_ln_g = (const float*)d_in[4];
    a.a_w_s = (const float*)d_in[5]; a.a_b_s = (const float*)d_in[6]; a.a_w_out = (const float*)d_in[7]; a.kv_g = (const float*)d_in[8]; a.w_k = (const float*)d_in[9];
    a.w_v = (const float*)d_in[10]; a.b_w_q = (const float*)d_in[11]; a.b_sinks = (const float*)d_in[12]; a.b_w_o = (const float*)d_in[13]; a.rel_bias = (const float*)d_in[14];
    a.ffn_w1 = (const float*)d_in[15]; a.ffn_w2 = (const float*)d_in[16]; a.final_g = (const float*)d_in[17];
    a.out = (float*)d_out; a.ws = (unsigned char*)d_ws;
    void* args[] = {&a};
    hipError_t e = hipLaunchCooperativeKernel((const void*)fwd_megakernel, dim3(grid), dim3(NTHREADS), args, LDS_BYTES, stream);
    if (e != hipSuccess) fprintf(stderr, "kernel_launch: cooperative launch failed: %s (grid %d)\n", hipGetErrorString(e), grid);
}
```
